# Optimizing an MI355X kernel written in HIP

```python
import jax, jax.numpy as jnp
from jax import lax
import numpy as np

D_MODEL = 1024
BATCH = 2
SEQ = 16384
DEPTH = 2

D_FF = 2816
N_SUB = 3
W_A = D_MODEL // 2
W_B = D_MODEL // 2
H_A = 8
DH_A = W_A // H_A
G_B = 8
DG_B = W_B // G_B
CONV_A = 4
CONV_B = 31
LRU_C = 8.0
W_C = D_MODEL
H_C = 8
DH_C = W_C // H_C
CHUNK = 128
EPS = 1e-6

kernel_name = "hybrid_rglru_conformer_gmlp_block"


def _rmsnorm(x, g):
    x32 = x.astype(jnp.float32)
    y = x32 * lax.rsqrt(jnp.mean(x32 * x32, axis=-1, keepdims=True) + EPS)
    return (y * g.astype(jnp.float32)).astype(x.dtype)


def _layernorm(x, g, b):
    x32 = x.astype(jnp.float32)
    mu = jnp.mean(x32, axis=-1, keepdims=True)
    var = jnp.mean(jnp.square(x32 - mu), axis=-1, keepdims=True)
    y = (x32 - mu) * lax.rsqrt(var + EPS)
    return (y * g.astype(jnp.float32) + b.astype(jnp.float32)).astype(x.dtype)


def _causal_dwconv(x, w, b):
    k = w.shape[0]
    y = lax.conv_general_dilated(
        x, w[:, None, :].astype(x.dtype), window_strides=(1,), padding=[(k - 1, 0)],
        dimension_numbers=("NWC", "WIO", "NWC"), feature_group_count=x.shape[-1])
    return y + b


def _swiglu(h, w13, w2):
    g, u = jnp.split(h @ w13, 2, axis=-1)
    return (jax.nn.silu(g) * u) @ w2


def _rg_lru(xr, gate_w, gate_b, lam):
    bsz, s, _ = xr.shape
    xh = xr.reshape(bsz, s, H_A, DH_A)
    gates = (jnp.einsum("bshd,hde->bshe", xh, gate_w) + gate_b).astype(jnp.float32)
    r, i = jnp.split(jax.nn.sigmoid(gates), 2, axis=-1)
    r = r.reshape(bsz, s, W_A)
    i = i.reshape(bsz, s, W_A)
    log_a = LRU_C * r * jax.nn.log_sigmoid(lam.astype(jnp.float32))
    a = jnp.exp(log_a)
    u = jnp.sqrt(-jnp.expm1(2.0 * log_a)) * (i * xr.astype(jnp.float32))

    def combine(left, right):
        a1, b1 = left
        a2, b2 = right
        return a1 * a2, a2 * b1 + b2

    _, h = lax.associative_scan(combine, (a, u), axis=1)
    return h.astype(xr.dtype)


def _mixer_ab(h, w_in, a_conv_w, a_conv_b, a_gate_w, a_gate_b, a_lam,
              b_conv_w, b_conv_b, b_norm_g, b_norm_b, w_out):
    z = h @ w_in
    a_gate, a_x, b_val, b_gate = jnp.split(z, [W_A, 2 * W_A, 2 * W_A + W_B], axis=-1)
    a_x = _causal_dwconv(a_x, a_conv_w, a_conv_b)
    y_a = _rg_lru(a_x, a_gate_w, a_gate_b, a_lam) * jax.nn.gelu(a_gate)
    v = b_val * jax.nn.sigmoid(b_gate)
    v = _causal_dwconv(v, b_conv_w, b_conv_b)
    bsz, s, _ = v.shape
    v = _layernorm(v.reshape(bsz, s, G_B, DG_B), b_norm_g.reshape(G_B, DG_B),
                   b_norm_b.reshape(G_B, DG_B)).reshape(bsz, s, W_B)
    y_b = jax.nn.silu(v)
    return jnp.concatenate([y_a, y_b], axis=-1) @ w_out


def _mixer_c(h, w_in, b_in, norm_g, norm_b, w_s, b_s, w_out):
    z = jax.nn.gelu(h @ w_in + b_in)
    u, v = jnp.split(z, 2, axis=-1)
    v = _layernorm(v, norm_g, norm_b)
    bsz, s, _ = v.shape
    vc = v.reshape(bsz, s // CHUNK, CHUNK, H_C, DH_C)
    mask = jnp.tril(jnp.ones((CHUNK, CHUNK), dtype=bool))
    ws = jnp.where(mask, w_s, jnp.zeros_like(w_s)).astype(v.dtype)
    mixed = jnp.einsum("hts,bnshd->bnthd", ws, vc) + jnp.transpose(b_s)[:, :, None]
    return (u * mixed.reshape(bsz, s, W_C)) @ w_out


def _sublayer(x, fn, pre_g, post_g, shift, scale, gate, res_w):
    h = _rmsnorm(x, pre_g) * (1.0 + scale[:, None, :]) + shift[:, None, :]
    y = _rmsnorm(fn(h), post_g)
    return x + res_w * (1.0 + gate[:, None, :]) * y


def setup_inputs(seed: int = 0) -> dict:
    key = jax.random.key(seed)
    ks = jax.random.split(key, 32)
    ne = (DEPTH + 1) // 2
    no = DEPTH // 2
    f32 = jnp.float32

    def nrm(k, shape, scale):
        return jax.random.normal(k, shape, f32) * scale

    u_lam = jax.random.uniform(ks[14], (ne, W_A), f32, minval=0.9, maxval=0.999)
    sa = u_lam ** (1.0 / LRU_C)
    a_lam = jnp.log(sa) - jnp.log1p(-sa)
    return {
        "x": nrm(ks[0], (BATCH, SEQ, D_MODEL), 1.0),
        "c": nrm(ks[1], (BATCH, D_MODEL), 1.0),
        "ada_w": nrm(ks[2], (DEPTH, D_MODEL, N_SUB * 3 * D_MODEL), 0.1 * D_MODEL ** -0.5),
        "ada_b": nrm(ks[3], (DEPTH, N_SUB * 3 * D_MODEL), 0.01),
        "norm_pre": 1.0 + nrm(ks[4], (DEPTH, N_SUB, D_MODEL), 0.02),
        "norm_post": 1.0 + nrm(ks[5], (DEPTH, N_SUB, D_MODEL), 0.02),
        "ffn_w13": nrm(ks[6], (DEPTH, 2, D_MODEL, 2 * D_FF), D_MODEL ** -0.5),
        "ffn_w2": nrm(ks[7], (DEPTH, 2, D_FF, D_MODEL), D_FF ** -0.5),
        "ab_w_in": nrm(ks[8], (ne, D_MODEL, 2 * W_A + 2 * W_B), D_MODEL ** -0.5),
        "a_conv_w": nrm(ks[9], (ne, CONV_A, W_A), CONV_A ** -0.5),
        "a_conv_b": nrm(ks[10], (ne, W_A), 0.01),
        "a_gate_w": nrm(ks[11], (ne, H_A, DH_A, 2 * DH_A), DH_A ** -0.5),
        "a_gate_b": nrm(ks[12], (ne, H_A, 2 * DH_A), 0.01),
        "a_lam": a_lam,
        "b_conv_w": nrm(ks[15], (ne, CONV_B, W_B), CONV_B ** -0.5),
        "b_conv_b": nrm(ks[16], (ne, W_B), 0.01),
        "b_norm_g": 1.0 + nrm(ks[17], (ne, W_B), 0.02),
        "b_norm_b": nrm(ks[18], (ne, W_B), 0.01),
        "ab_w_out": nrm(ks[19], (ne, W_A + W_B, D_MODEL), (W_A + W_B) ** -0.5),
        "c_w_in": nrm(ks[20], (no, D_MODEL, 2 * W_C), D_MODEL ** -0.5),
        "c_b_in": nrm(ks[21], (no, 2 * W_C), 0.01),
        "c_norm_g": 1.0 + nrm(ks[22], (no, W_C), 0.02),
        "c_norm_b": nrm(ks[23], (no, W_C), 0.01),
        "c_w_s": nrm(ks[24], (no, H_C, CHUNK, CHUNK), 0.5 * CHUNK ** -0.5),
        "c_b_s": 1.0 + nrm(ks[25], (no, H_C, CHUNK), 0.01),
        "c_w_out": nrm(ks[26], (no, W_C, D_MODEL), W_C ** -0.5),
    }


def reference(x, c, ada_w, ada_b, norm_pre, norm_post, ffn_w13, ffn_w2,
              ab_w_in, a_conv_w, a_conv_b, a_gate_w, a_gate_b, a_lam,
              b_conv_w, b_conv_b, b_norm_g, b_norm_b, ab_w_out,
              c_w_in, c_b_in, c_norm_g, c_norm_b, c_w_s, c_b_s, c_w_out):
    bsz = x.shape[0]
    c_act = jax.nn.silu(c)
    for l in range(DEPTH):
        mod = (c_act @ ada_w[l] + ada_b[l]).reshape(bsz, N_SUB, 3, D_MODEL)

        def ffn_pre(h, l=l):
            return _swiglu(h, ffn_w13[l, 0], ffn_w2[l, 0])

        def ffn_post(h, l=l):
            return _swiglu(h, ffn_w13[l, 1], ffn_w2[l, 1])

        if l % 2 == 0:
            k = l // 2

            def mixer(h, k=k):
                return _mixer_ab(h, ab_w_in[k], a_conv_w[k], a_conv_b[k], a_gate_w[k],
                                 a_gate_b[k], a_lam[k], b_conv_w[k], b_conv_b[k],
                                 b_norm_g[k], b_norm_b[k], ab_w_out[k])
        else:
            k = l // 2

            def mixer(h, k=k):
                return _mixer_c(h, c_w_in[k], c_b_in[k], c_norm_g[k], c_norm_b[k],
                                c_w_s[k], c_b_s[k], c_w_out[k])

        x = _sublayer(x, ffn_pre, norm_pre[l, 0], norm_post[l, 0],
                      mod[:, 0, 0], mod[:, 0, 1], mod[:, 0, 2], 0.5)
        x = _sublayer(x, mixer, norm_pre[l, 1], norm_post[l, 1],
                      mod[:, 1, 0], mod[:, 1, 1], mod[:, 1, 2], 1.0)
        x = _sublayer(x, ffn_post, norm_pre[l, 2], norm_post[l, 2],
                      mod[:, 2, 0], mod[:, 2, 1], mod[:, 2, 2], 0.5)
    return x
```

```cpp
#include <hip/hip_runtime.h>
#include <hip/hip_cooperative_groups.h>
#include <cstdio>
#include <cstdint>
namespace cg = cooperative_groups;
namespace pg8 {
#define PG8_LAS __attribute__((address_space(3)))
typedef unsigned short bf16_t;
typedef short bf16x8 __attribute__((ext_vector_type(8)));
typedef float f32x4 __attribute__((ext_vector_type(4)));
typedef unsigned u32x4 __attribute__((ext_vector_type(4)));
constexpr int BM = 256, BK = 64, HALF = 128, HTB = HALF * BK * 2  , STAGE_BYTES = 8 * HTB, NXCD = 8, WGM = 8;

__host__ __device__ __forceinline__ int lds_byte(int r, int c) { const int st = (r >> 4) * 2 + (c >> 5), rr = r & 15, cc = c & 31, ob = rr * 64 + cc * 2; return st * 1024 + (ob ^ (((ob >> 9) & 1) << 5)); }
__host__ __device__ __forceinline__ void stage_rc(int b, int& R, int& C) { const int st = b / 1024, sb = b % 1024, swz = sb ^ (((sb >> 9) & 1) << 5); R = (st >> 1) * 16 + swz / 64; C = (st & 1) * 32 + (swz % 64) / 2; }
__host__ __device__ __forceinline__ int perm32(int rho) { const int n = rho >> 4, i = rho & 15; return 8 * (i >> 2) + 4 * n + (i & 3); }

struct Unit { int pm, pn; };
struct Gemm { const bf16_t* A; const bf16_t* Bt; int M, N, K; };

struct StaticOrder {
    int nM, nN, nwg, G, c;
    __host__ __device__ void init(int M, int N, int G_, int c_) { nM = M / BM; nN = N / BM; nwg = nM * nN; G = G_; c = c_; }
    __host__ __device__ bool next(int i, Unit& u) const {
        const long L = (long)i * G + c; if (L >= nwg) return false;
        int wgid = (int)L; { const int q = nwg / NXCD, r = nwg % NXCD, xcd = wgid % NXCD, off = wgid / NXCD; wgid = (xcd < r ? xcd * (q + 1) : r * (q + 1) + (xcd - r) * q) + off; }
        const int nig = WGM * nN, gid = wgid / nig, fm = gid * WGM, gsz = (nM - fm) < WGM ? (nM - fm) : WGM;
        u.pm = fm + ((wgid % nig) % gsz); u.pn = (wgid % nig) / gsz; return true;
    }
    __device__ __forceinline__ void a_ready(const Unit&) const {}
    __device__ __forceinline__ void done(const Unit&) const {}
};

__device__ __forceinline__ unsigned cvt_pk_bf16(float lo, float hi) { unsigned r; asm volatile("v_cvt_pk_bf16_f32 %0, %1, %2" : "=v"(r) : "v"(lo), "v"(hi)); return r; }
typedef float f32x2 __attribute__((ext_vector_type(2)));
__device__ __forceinline__ float fast_sigmoid(float x) { return __builtin_amdgcn_rcpf(1.0f + __expf(-x)); }
__device__ __forceinline__ float gelu_tanh(float x) { const float u = 1.5957691216f * (x + 0.044715f * x * x * x); return x * fast_sigmoid(u); }
template <int MODE> struct EpiX {
    static constexpr bool PERM = true, AFTER_DRAIN = false;
    bf16_t* O; int ldc; const float* bias; float* st0; float* st1;
    __device__ __forceinline__ void operator()(const f32x4 (&acc)[2][2][4][2], const Unit& u, int wr, int wc, int fr, int fq) const {
        const int row0 = u.pm * BM + wr * 64 + fr;
        if constexpr (MODE == 1) {
            const int col0 = u.pn * HALF + wc * 32 + 8 * fq;
#pragma unroll
            for (int ai = 0; ai < 2; ++ai)
#pragma unroll
                for (int m = 0; m < 4; ++m) { bf16_t* rowp = O + (size_t)(row0 + ai * HALF + m * 16) * ldc + col0;
                    const f32x4 g0 = acc[ai][0][m][0], g1 = acc[ai][0][m][1], u0 = acc[ai][1][m][0], u1 = acc[ai][1][m][1];
                    float r[8];
#pragma unroll
                    for (int e = 0; e < 4; ++e) { r[e] = g0[e] * fast_sigmoid(g0[e]) * u0[e]; r[4 + e] = g1[e] * fast_sigmoid(g1[e]) * u1[e]; }
                    u32x4 w; w.x = cvt_pk_bf16(r[0], r[1]); w.y = cvt_pk_bf16(r[2], r[3]); w.z = cvt_pk_bf16(r[4], r[5]); w.w = cvt_pk_bf16(r[6], r[7]);
                    *(u32x4*)rowp = w; }
        } else {
            const int col0 = u.pn * BM + wc * 32 + 8 * fq;
            f32x4 bv[2][2];
#pragma unroll
            for (int bj = 0; bj < 2; ++bj)
#pragma unroll
                for (int n = 0; n < 2; ++n) bv[bj][n] = (MODE == 3) ? *(const f32x4*)(bias + col0 + bj * HALF + 4 * n) : (f32x4){0.f, 0.f, 0.f, 0.f};
#pragma unroll
            for (int ai = 0; ai < 2; ++ai)
#pragma unroll
                for (int m = 0; m < 4; ++m) { const int row = row0 + ai * HALF + m * 16; bf16_t* rowp = O + (size_t)row * ldc + col0;
                    float s1 = 0.f, s2 = 0.f;
#pragma unroll
                    for (int bj = 0; bj < 2; ++bj) { f32x4 v0 = acc[ai][bj][m][0], v1 = acc[ai][bj][m][1];
                        if constexpr (MODE == 3) { v0 = v0 + bv[bj][0]; v1 = v1 + bv[bj][1];
#pragma unroll
                            for (int e = 0; e < 4; ++e) { v0[e] = gelu_tanh(v0[e]); v1[e] = gelu_tanh(v1[e]); } }
                        if constexpr (MODE == 2 || MODE == 3) {
#pragma unroll
                            for (int e = 0; e < 4; ++e) { s1 += v0[e] + v1[e]; s2 += v0[e] * v0[e] + v1[e] * v1[e]; } }
                        u32x4 w; w.x = cvt_pk_bf16(v0[0], v0[1]); w.y = cvt_pk_bf16(v0[2], v0[3]); w.z = cvt_pk_bf16(v1[0], v1[1]); w.w = cvt_pk_bf16(v1[2], v1[3]);
                        *(u32x4*)(rowp + bj * HALF) = w; }
                    if constexpr (MODE == 2) { s2 += __shfl_xor(s2, 16); s2 += __shfl_xor(s2, 32); if (fq == 0) st0[(size_t)row * 16 + u.pn * 4 + wc] = s2; }
                    if constexpr (MODE == 3) { if (u.pn >= 4) { s1 += __shfl_xor(s1, 16); s1 += __shfl_xor(s1, 32); s2 += __shfl_xor(s2, 16); s2 += __shfl_xor(s2, 32);
                            if (fq == 0) { st0[(size_t)row * 16 + (u.pn - 4) * 4 + wc] = s1; st1[(size_t)row * 16 + (u.pn - 4) * 4 + wc] = s2; } } }
                }
        }
    }
};
template <class Epi, class Sched, bool ALIGN_EPI = false, bool SP2 = false>
__device__ __forceinline__ void gemm_phase(PG8_LAS unsigned char* lds, const Gemm g, const Sched& S, const Epi& E) {
    int tid_ = threadIdx.x; asm volatile("" : "+v"(tid_));
    const int tid = tid_, wid = __builtin_amdgcn_readfirstlane(tid >> 6), lane = tid & 63, wr = wid >> 2, wc = wid & 3, fr = lane & 15, fq = lane >> 4;
    const int K = g.K, nt = K / BK;
    unsigned voffA[2], voffB[2];
#pragma unroll
    for (int i = 0; i < 2; ++i) { int R, C; stage_rc(tid * 16 + i * 8192, R, C); const int Rb = Epi::PERM ? ((R & ~31) + perm32(R & 31)) : R;
        voffA[i] = (unsigned)(R * K + C) * 2u; voffB[i] = (unsigned)(Rb * K + C) * 2u; }
    const size_t kstep = (size_t)(BK * 2);
    const size_t hstep = (size_t)HALF * K * 2;
    const size_t tstep = 2 * hstep;
    const unsigned ldsw = (unsigned)wid * 1024u;
    const int aoff = lds_byte(wr * 64 + fr, fq * 8), boff = lds_byte(wc * 32 + fr, fq * 8);
#define PG8_SA(b, h) (((b) * 2 + (h)) * HTB)
#define PG8_SB(b, h) ((4 + (b) * 2 + (h)) * HTB)
#define PG8_STAGE(bufoff, gbase, voff) do { _Pragma("unroll") for (int _i = 0; _i < 2; ++_i) \
        __builtin_amdgcn_global_load_lds((const unsigned*)((const char*)(gbase) + (voff)[_i]), (PG8_LAS unsigned*)(lds + (bufoff) + ldsw + _i * 8192), 16, 0, 0); } while (0)
#define PG8_LDA(dst, b, h) do { _Pragma("unroll") for (int m = 0; m < 4; ++m) _Pragma("unroll") for (int k = 0; k < 2; ++k) dst[m][k] = *(const PG8_LAS bf16x8*)(lds + PG8_SA(b, h) + aoff + m * 2048 + k * 1024); } while (0)
#define PG8_LDB(dst, b, h) do { _Pragma("unroll") for (int n = 0; n < 2; ++n) _Pragma("unroll") for (int k = 0; k < 2; ++k) dst[n][k] = *(const PG8_LAS bf16x8*)(lds + PG8_SB(b, h) + boff + n * 2048 + k * 1024); } while (0)
#define PG8_MMA(ai, bj, At, Bt) do { __builtin_amdgcn_s_setprio(1); _Pragma("unroll") for (int m = 0; m < 4; ++m) _Pragma("unroll") for (int n = 0; n < 2; ++n) _Pragma("unroll") for (int k = 0; k < 2; ++k) \
        acc[ai][bj][m][n] = __builtin_amdgcn_mfma_f32_16x16x32_bf16(Bt[n][k], At[m][k], acc[ai][bj][m][n], 0, 0, 0); __builtin_amdgcn_s_setprio(0); } while (0)
#define PG8_WAIT_V(n) asm volatile("s_waitcnt vmcnt(" #n ")" ::: "memory")
#define PG8_WAIT_L(n) asm volatile("s_waitcnt lgkmcnt(" #n ")" ::: "memory")
#define PG8_BAR __builtin_amdgcn_s_barrier()
#define PG8_SCHED __builtin_amdgcn_sched_barrier(0)
    Unit cur, nxt; int ui = 0;
    if (!S.next(0, cur)) return;
    f32x4 acc[2][2][4][2];
#pragma unroll
    for (int a = 0; a < 2; ++a)
#pragma unroll
        for (int b = 0; b < 2; ++b)
#pragma unroll
            for (int m = 0; m < 4; ++m)
#pragma unroll
                for (int n = 0; n < 2; ++n) acc[a][b][m][n] = (f32x4){0.f, 0.f, 0.f, 0.f};
    bf16x8 At[4][2], B0[2][2], B1[2][2];
    const char* cA = (const char*)g.A + (size_t)cur.pm * tstep; const char* cB = (const char*)g.Bt + (size_t)cur.pn * tstep;
    S.a_ready(cur);
    if constexpr (SP2) {
        PG8_STAGE(PG8_SB(0, 0), cB, voffB); PG8_STAGE(PG8_SB(0, 1), cB + hstep, voffB); PG8_STAGE(PG8_SA(0, 0), cA, voffA); PG8_STAGE(PG8_SA(0, 1), cA + hstep, voffA);
        if (wr == 1) PG8_BAR;
        PG8_WAIT_V(2); PG8_BAR;
        PG8_STAGE(PG8_SB(1, 0), cB + kstep, voffB); PG8_STAGE(PG8_SA(1, 0), cA + kstep, voffA); PG8_STAGE(PG8_SB(1, 1), cB + hstep + kstep, voffB);
        PG8_WAIT_V(6); PG8_BAR;
    } else {
        PG8_STAGE(PG8_SB(0, 0), cB, voffB); PG8_STAGE(PG8_SA(0, 0), cA, voffA); PG8_STAGE(PG8_SB(0, 1), cB + hstep, voffB); PG8_STAGE(PG8_SA(0, 1), cA + hstep, voffA);
        if (wr == 1) PG8_BAR;
        PG8_WAIT_V(4); PG8_BAR;
        PG8_STAGE(PG8_SB(1, 0), cB + kstep, voffB); PG8_STAGE(PG8_SA(1, 0), cA + kstep, voffA); PG8_STAGE(PG8_SB(1, 1), cB + hstep + kstep, voffB);
        PG8_WAIT_V(6); PG8_BAR;
    }
    for (;;) {
        const bool has_next = S.next(ui + 1, nxt);
        const char* nA = has_next ? (const char*)g.A + (size_t)nxt.pm * tstep : cA; const char* nB = has_next ? (const char*)g.Bt + (size_t)nxt.pn * tstep : cB;
        for (int t = 0; t < nt; t += 2) {
            const bool last = (t == nt - 2);
            const char* a1 = cA + (size_t)(t + 1) * kstep;
            const char* a2 = last ? nA : cA + (size_t)(t + 2) * kstep; const char* b2 = last ? nB : cB + (size_t)(t + 2) * kstep;
            const char* a3 = a2 + kstep; const char* b3 = b2 + kstep;
            if (last && has_next) S.a_ready(nxt);
            if constexpr (SP2) {
            PG8_LDB(B0, 0, 0); PG8_LDB(B1, 0, 1); PG8_SCHED; PG8_LDA(At, 0, 0); PG8_STAGE(PG8_SA(1, 1), a1 + hstep, voffA);
            PG8_WAIT_V(8); PG8_WAIT_L(0); PG8_BAR; PG8_MMA(0, 0, At, B0); PG8_MMA(0, 1, At, B1); PG8_BAR; PG8_SCHED;
            PG8_LDA(At, 0, 1); PG8_STAGE(PG8_SB(0, 0), b2, voffB); PG8_STAGE(PG8_SB(0, 1), b2 + hstep, voffB); PG8_STAGE(PG8_SA(0, 0), a2, voffA);
            PG8_WAIT_V(8); PG8_WAIT_L(0); PG8_BAR; PG8_MMA(1, 0, At, B0); PG8_MMA(1, 1, At, B1); PG8_BAR; PG8_SCHED;
            PG8_LDB(B0, 1, 0); PG8_LDB(B1, 1, 1); PG8_SCHED; PG8_LDA(At, 1, 0); PG8_STAGE(PG8_SA(0, 1), a2 + hstep, voffA);
            PG8_WAIT_V(8); PG8_WAIT_L(0); PG8_BAR; PG8_MMA(0, 0, At, B0); PG8_MMA(0, 1, At, B1); PG8_BAR; PG8_SCHED;
            PG8_LDA(At, 1, 1); PG8_STAGE(PG8_SB(1, 0), b3, voffB); PG8_STAGE(PG8_SB(1, 1), b3 + hstep, voffB); PG8_STAGE(PG8_SA(1, 0), a3, voffA);
            PG8_WAIT_V(8); PG8_WAIT_L(0); PG8_BAR; PG8_MMA(1, 0, At, B0); PG8_MMA(1, 1, At, B1); PG8_BAR; PG8_SCHED;
            } else {
            PG8_LDB(B0, 0, 0); PG8_SCHED; PG8_LDA(At, 0, 0); PG8_STAGE(PG8_SA(1, 1), a1 + hstep, voffA);
            PG8_WAIT_L(8); PG8_BAR; PG8_WAIT_L(0); PG8_MMA(0, 0, At, B0); PG8_BAR; PG8_SCHED;
            PG8_LDB(B1, 0, 1); PG8_STAGE(PG8_SB(0, 0), b2, voffB);
            PG8_BAR; PG8_WAIT_L(0); PG8_MMA(0, 1, At, B1); PG8_BAR;
            PG8_LDA(At, 0, 1); PG8_STAGE(PG8_SA(0, 0), a2, voffA);
            PG8_BAR; PG8_WAIT_L(0); PG8_MMA(1, 0, At, B0); PG8_BAR; PG8_SCHED;
            PG8_STAGE(PG8_SB(0, 1), b2 + hstep, voffB);
            PG8_WAIT_V(6); PG8_BAR; PG8_MMA(1, 1, At, B1); PG8_BAR;
            PG8_LDB(B0, 1, 0); PG8_SCHED; PG8_LDA(At, 1, 0); PG8_STAGE(PG8_SA(0, 1), a2 + hstep, voffA);
            PG8_WAIT_L(8); PG8_BAR; PG8_WAIT_L(0); PG8_MMA(0, 0, At, B0); PG8_BAR; PG8_SCHED;
            PG8_LDB(B1, 1, 1); PG8_STAGE(PG8_SB(1, 0), b3, voffB);
            PG8_BAR; PG8_WAIT_L(0); PG8_MMA(0, 1, At, B1); PG8_BAR;
            PG8_LDA(At, 1, 1); PG8_STAGE(PG8_SA(1, 0), a3, voffA);
            PG8_BAR; PG8_WAIT_L(0); PG8_MMA(1, 0, At, B0); PG8_BAR; PG8_SCHED;
            PG8_STAGE(PG8_SB(1, 1), b3 + hstep, voffB);
            PG8_WAIT_V(6); PG8_BAR; PG8_MMA(1, 1, At, B1); PG8_BAR;
            }
        }
        if constexpr (ALIGN_EPI) { if (wr == 0) PG8_BAR; }
        if constexpr (!Epi::AFTER_DRAIN) { E(acc, cur, wr, wc, fr, fq); S.done(cur); }
        if (!has_next) break;
#pragma unroll
        for (int a = 0; a < 2; ++a)
#pragma unroll
            for (int b = 0; b < 2; ++b)
#pragma unroll
                for (int m = 0; m < 4; ++m)
#pragma unroll
                    for (int n = 0; n < 2; ++n) acc[a][b][m][n] = (f32x4){0.f, 0.f, 0.f, 0.f};
        cur = nxt; cA = nA; cB = nB; ++ui;
        if constexpr (ALIGN_EPI) { if (wr == 1) PG8_BAR; }
    }
    PG8_WAIT_V(0);
    if constexpr (!ALIGN_EPI) { if (wr == 0) PG8_BAR; }
    PG8_BAR;
    if constexpr (Epi::AFTER_DRAIN) { E.fused(acc, cur, wr, wc, fr, fq, lds, wid, lane); S.done(cur); }
#undef PG8_SA
#undef PG8_SB
#undef PG8_STAGE
#undef PG8_LDA
#undef PG8_LDB
#undef PG8_MMA
#undef PG8_WAIT_V
#undef PG8_WAIT_L
#undef PG8_BAR
#undef PG8_SCHED
}
}
#define GAS __attribute__((address_space(1)))
#define LAS __attribute__((address_space(3)))
typedef unsigned short bf16;
typedef unsigned v4u __attribute__((ext_vector_type(4)));
typedef float f32x4 __attribute__((ext_vector_type(4)));
typedef short bf16x8 __attribute__((ext_vector_type(8)));
typedef GAS unsigned gu32;
typedef GAS unsigned long long gu64;
#define RLX_AGENT __ATOMIC_RELAXED, __HIP_MEMORY_SCOPE_AGENT
#define LDS_WAIT() asm volatile("s_waitcnt lgkmcnt(0)" ::: "memory")
#define VM_WAIT() asm volatile("s_waitcnt vmcnt(0)" ::: "memory")
__device__ __forceinline__ unsigned long long rt() { return __builtin_amdgcn_s_memrealtime(); }
__device__ __forceinline__ unsigned f2bf(float f) { unsigned u = __builtin_bit_cast(unsigned, f); return (u + 0x7fffu + ((u >> 16) & 1u)) >> 16; }
__device__ __forceinline__ unsigned pk2(float lo, float hi) { return f2bf(lo) | (f2bf(hi) << 16); }
#define XB_TMO      128
#define XB_XCNT(j)  (256  + 64 * (j))
#define XB_XSUB(j)  (1280 + 64 * (j))
#define XB_XGEN(j)  (2304 + 64 * (j))
#define XB_TOP      3328
#define XB_TOPGEN   3392
#define XCD_BAR_WORDS 3456
#define XB_SPIN_CAP (1u << 18)

__device__ __forceinline__ unsigned xb_ld(unsigned* p)              { return __hip_atomic_load(p, __ATOMIC_RELAXED, __HIP_MEMORY_SCOPE_AGENT); }
__device__ __forceinline__ unsigned xb_add(unsigned* p, unsigned v) { return __hip_atomic_fetch_add(p, v, __ATOMIC_RELAXED, __HIP_MEMORY_SCOPE_AGENT); }
__device__ __forceinline__ unsigned xb_xcc_id() { return (unsigned)__builtin_amdgcn_s_getreg((3 << 11) | 20) & 0xFu; }
#define XB_SPIN(cond, bar) do { unsigned _sp = 0; while (cond) { __builtin_amdgcn_s_sleep(1); \
    if ((++_sp & 255u) == 0u) { if (xb_ld(&(bar)[XB_TMO])) break; if (_sp > XB_SPIN_CAP) { atomicAdd(&(bar)[XB_TMO], 1u); break; } } } } while (0)

struct XcdBarrier {
    unsigned* bar; unsigned x;
    volatile LAS unsigned* st;
};

__device__ __forceinline__ XcdBarrier xcd_barrier_post(unsigned* bar, volatile LAS unsigned* st) {
    XcdBarrier b; b.bar = bar; b.x = xb_xcc_id(); b.st = st;
    if (threadIdx.x == 0) (void)xb_add(&bar[XB_XCNT(b.x)], 1u);
    return b;
}
__device__ __forceinline__ void xcd_barrier_complete(unsigned* bar, unsigned x, unsigned& nloc, unsigned& nx) {
    const unsigned G = gridDim.x * gridDim.y * gridDim.z;
    unsigned sum, cnt, mine, sp = 0u;
    for (;;) {
        sum = 0u; cnt = 0u; mine = 0u;
#pragma unroll
        for (unsigned j = 0; j < 16; ++j) { const unsigned c = xb_ld(&bar[XB_XCNT(j)]); sum += c; cnt += (c > 0u) ? 1u : 0u; mine = (j == x) ? c : mine; }
        if (sum == G) break;
        __builtin_amdgcn_s_sleep(1);
        if ((++sp & 255u) == 0u) { if (xb_ld(&bar[XB_TMO])) break; if (sp > XB_SPIN_CAP) { atomicAdd(&bar[XB_TMO], 1u); break; } }
    }
    nloc = mine > 0u ? mine : 1u; nx = cnt > 0u ? cnt : 1u;
}

__device__ __forceinline__ void xcd_barrier(const XcdBarrier& b) {
    asm volatile("s_waitcnt vmcnt(0)" ::: "memory");
    __syncthreads();
    if (threadIdx.x == 0) {
        unsigned* bar = b.bar;
        __builtin_amdgcn_s_waitcnt(0);
        unsigned nloc = b.st[0], nx = b.st[1];
        if (nloc == 0u) { xcd_barrier_complete(bar, b.x, nloc, nx); b.st[0] = nloc; b.st[1] = nx; }
        const unsigned old = xb_add(&bar[XB_XSUB(b.x)], 1u);
        const unsigned gen = old / nloc;
        if (old + 1u == (gen + 1u) * nloc) {
            __builtin_amdgcn_fence(__ATOMIC_RELEASE, "agent");
            asm volatile("s_waitcnt vmcnt(0)" ::: "memory");
            const unsigned og = xb_add(&bar[XB_TOP], 1u);
            const unsigned tg = og / nx;
            if (og + 1u == (tg + 1u) * nx) xb_add(&bar[XB_TOPGEN], 1u);
            else XB_SPIN(xb_ld(&bar[XB_TOPGEN]) == tg, bar);
            __builtin_amdgcn_fence(__ATOMIC_ACQUIRE, "agent");
            xb_add(&bar[XB_XGEN(b.x)], 1u);
            asm volatile("s_waitcnt vmcnt(0)" ::: "memory");
        } else {
            XB_SPIN(xb_ld(&bar[XB_XGEN(b.x)]) == gen, bar);
            __builtin_amdgcn_fence(__ATOMIC_ACQUIRE, "agent");
            asm volatile("s_waitcnt vmcnt(0)" ::: "memory");
        }
    }
    __syncthreads();
}

constexpr int NWAVES = 8, NTHR = NWAVES * 64;
constexpr int BATCH = 2, SEQ = 16384, D = 1024, FF = 2816, M = BATCH * SEQ;
constexpr int NCHUNK = M / 128;
constexpr float EPS = 1e-6f;
constexpr size_t MiB = 1u << 20;
constexpr size_t WS_CTL = 0, CTL_ZERO_BYTES = 1 * MiB;
constexpr size_t WS_W = 1 * MiB;
constexpr size_t W13_BYTES = (size_t)2 * FF * D * 2, W2_BYTES = (size_t)D * FF * 2, WIN_BYTES = (size_t)2048 * D * 2, WOUT_BYTES = (size_t)D * D * 2;
constexpr size_t LW_W13 = 0, LW_W2 = 2 * W13_BYTES, LW_WIN = LW_W2 + 2 * W2_BYTES, LW_WOUT = LW_WIN + WIN_BYTES, LAYER_W_BYTES = LW_WOUT + WOUT_BYTES;
static_assert(LAYER_W_BYTES == 39 * MiB, "weights");
constexpr size_t WS_XN = 80 * MiB;
constexpr size_t WS_ACT = 144 * MiB;
constexpr size_t WS_PC = WS_ACT + 128 * MiB;
constexpr size_t WS_Y = 320 * MiB;
constexpr size_t WS_MISC = 384 * MiB;
constexpr size_t WS_ST0 = WS_MISC, WS_ST1 = WS_MISC + 2 * MiB, WS_ST2 = WS_MISC + 4 * MiB;
constexpr size_t WS_MODP = WS_MISC + 6 * MiB;
constexpr size_t WS_PAR = WS_MISC + 11 * MiB;
constexpr size_t WS_WSB = WS_MISC + 12 * MiB;
constexpr size_t WS_GWT = WS_MISC + 12 * MiB + 512 * 1024;
constexpr size_t WS_SUMM = WS_MISC + 13 * MiB;
constexpr size_t WS_END = WS_MISC + 14 * MiB;
static_assert(WS_W + 2 * LAYER_W_BYTES <= WS_XN && WS_PC + (size_t)M * 512 * 2 <= WS_Y, "d_ws map");
constexpr int CW_BAR = 4096;
constexpr int RING_BYTES = 131072, LDS_BYTES = 147456, LDSCTL_OFF = LDS_BYTES - 512, MISC_OFF = LDSCTL_OFF;

struct Args { const float* in[26]; float* out; unsigned char* ws; };
enum { I_X = 0, I_C, I_ADAW, I_ADAB, I_NPRE, I_NPOST, I_W13, I_W2, I_ABWIN, I_ACW, I_ACB, I_AGW, I_AGB, I_ALAM, I_BCW, I_BCB, I_BNG, I_BNB, I_ABWOUT, I_CWIN, I_CBIN, I_CNG, I_CNB, I_CWS, I_CBS, I_CWOUT };

__device__ __forceinline__ float wave_sum(float v) {
#pragma unroll
    for (int o = 1; o < 64; o <<= 1) v += __shfl_xor(v, o);
    return v;
}
__device__ __forceinline__ float bf2f(unsigned h) { return __uint_as_float(h << 16); }
__device__ __forceinline__ float bflo(unsigned w) { return __uint_as_float(w << 16); }
__device__ __forceinline__ float bfhi(unsigned w) { return __uint_as_float(w & 0xffff0000u); }
__device__ __forceinline__ float fsig(float x) { return __builtin_amdgcn_rcpf(1.0f + __expf(-x)); }
__device__ __forceinline__ float gelu_t(float x) { const float u = 1.5957691216f * (x + 0.044715f * x * x * x); return x * fsig(u); }
typedef unsigned u32x2 __attribute__((ext_vector_type(2)));

__device__ __forceinline__ void p0_transpose_item(const float* W, int K, int N, bf16* WT, int mode, LAS float* scr, int item, int lane) {
    const int nblk = N / 32, kb = item / nblk, nb = item % nblk, k0 = 64 * kb, n0 = 32 * nb;
    int rowbase = n0;
    if (mode == 1) { if (n0 < FF) rowbase = 256 * (n0 >> 7) + (n0 & 127); else { const int c = n0 - FF; rowbase = 256 * (c >> 7) + 128 + (c & 127); } }
#pragma unroll 8
    for (int i = 0; i < 32; ++i) { const int kk = 2 * i + (lane >> 5); scr[kk * 33 + (lane & 31)] = W[(size_t)(k0 + kk) * N + n0 + (lane & 31)]; }
    LDS_WAIT(); asm volatile("" ::: "memory");
    const int c = lane & 7;
#pragma unroll
    for (int j = 0; j < 4; ++j) { const int n = (lane >> 3) + 8 * j; const LAS float* s = scr + (8 * c) * 33 + n;
        v4u o; o.x = pk2(s[0 * 33], s[1 * 33]); o.y = pk2(s[2 * 33], s[3 * 33]); o.z = pk2(s[4 * 33], s[5 * 33]); o.w = pk2(s[6 * 33], s[7 * 33]);
        *(GAS v4u*)(WT + (size_t)(rowbase + n) * K + k0 + 8 * c) = o; }
    LDS_WAIT(); asm volatile("" ::: "memory");
}

template <bool RES, bool NORM>
__device__ __forceinline__ void trans_phase(int gw, int NGW, int lane_, const float* xin, float* xout, const bf16* Y, const float* st,
                                            const float* A1p, const float* A2p, const float* A3p, bf16* XN) {
    int lane = lane_; asm volatile("" : "+v"(lane));
    for (int blk = gw; blk < M / 16; blk += NGW) {
        const int rbase = blk * 16, b = rbase / SEQ;
        f32x4 A1[4], A2[4], A3[4];
#pragma unroll
        for (int j = 0; j < 4; ++j) {
            if (RES) A1[j] = *(const f32x4*)(A1p + b * 3072 + 4 * lane + 256 * j);
            if (NORM) { A2[j] = *(const f32x4*)(A2p + b * 3072 + 4 * lane + 256 * j); A3[j] = *(const f32x4*)(A3p + b * 3072 + 4 * lane + 256 * j); }
        }
#pragma unroll 1
        for (int r4 = 0; r4 < 16; r4 += 4) {
            f32x4 xv[4][4]; u32x2 yv[4][4]; float sp[4];
#pragma unroll
            for (int r = 0; r < 4; ++r) { const size_t row = (size_t)(rbase + r4 + r);
#pragma unroll
                for (int j = 0; j < 4; ++j) xv[r][j] = *(const f32x4*)(xin + row * D + 4 * lane + 256 * j);
                if (RES) {
#pragma unroll
                    for (int j = 0; j < 4; ++j) yv[r][j] = *(const u32x2*)(Y + row * D + 4 * lane + 256 * j);
                    sp[r] = st[row * 16 + (lane & 15)]; } }
#pragma unroll
            for (int r = 0; r < 4; ++r) { const size_t row = (size_t)(rbase + r4 + r);
                if (RES) {
                    float ss = sp[r]; ss += __shfl_xor(ss, 1); ss += __shfl_xor(ss, 2); ss += __shfl_xor(ss, 4); ss += __shfl_xor(ss, 8);
                    const float rstd = rsqrtf(ss * (1.0f / D) + EPS);
#pragma unroll
                    for (int j = 0; j < 4; ++j) { const f32x4 y = (f32x4){bflo(yv[r][j].x), bfhi(yv[r][j].x), bflo(yv[r][j].y), bfhi(yv[r][j].y)};
                        xv[r][j] = xv[r][j] + A1[j] * y * rstd;
                        *(f32x4*)(xout + row * D + 4 * lane + 256 * j) = xv[r][j]; }
                }
                if (NORM) {
                    float q = 0.f;
#pragma unroll
                    for (int j = 0; j < 4; ++j) q += (xv[r][j].x * xv[r][j].x + xv[r][j].y * xv[r][j].y) + (xv[r][j].z * xv[r][j].z + xv[r][j].w * xv[r][j].w);
                    q = wave_sum(q);
                    const float r2 = rsqrtf(q * (1.0f / D) + EPS);
#pragma unroll
                    for (int j = 0; j < 4; ++j) { const f32x4 h = xv[r][j] * r2 * A2[j] + A3[j];
                        u32x2 w; w.x = pg8::cvt_pk_bf16(h.x, h.y); w.y = pg8::cvt_pk_bf16(h.z, h.w);
                        *(u32x2*)(XN + row * D + 4 * lane + 256 * j) = w; }
                }
            }
        }
    }
}

__device__ __forceinline__ void m1_chunk(const Args& a, unsigned char* ws, LAS unsigned char* lds, int ci, int w, int lane_) {
    int lane = lane_; asm volatile("" : "+v"(lane));
    const bf16* Z = (const bf16*)(ws + WS_ACT);
    float* HL = (float*)(ws + WS_Y); bf16* PC = (bf16*)(ws + WS_PC); float* SUMM = (float*)(ws + WS_SUMM); bf16* YCAT = (bf16*)(ws + WS_XN);
    const int ch = w * 64 + lane, row0 = ci * 128; const bool first = (ci % (SEQ / 128)) == 0;
    {
        LAS bf16* xcl = (LAS bf16*)(lds + w * 10752);
        LAS float* gl = (LAS float*)(lds + w * 10752 + 2304);
        const int fr = lane & 15, fq = lane >> 4;
        const bf16* GWT = (const bf16*)(ws + WS_GWT);
        bf16x8 gB[8][2];
#pragma unroll
        for (int et = 0; et < 8; ++et)
#pragma unroll
            for (int ks = 0; ks < 2; ++ks) gB[et][ks] = *(const bf16x8*)(GWT + ((size_t)w * 128 + et * 16 + fr) * 64 + ks * 32 + 8 * fq);
        const float* cwp = a.in[I_ACW];
        const float cw0 = cwp[ch], cw1 = cwp[512 + ch], cw2 = cwp[1024 + ch], cw3 = cwp[1536 + ch], cb = a.in[I_ACB][ch];
        const float lam = a.in[I_ALAM][ch];
        const float c8 = -8.0f * log1pf(expf(-lam));
        const float gbr = a.in[I_AGB][w * 128 + lane], gbi = a.in[I_AGB][w * 128 + 64 + lane];
        const bf16* zx = Z + 512 + ch;
        float xm3 = 0.f, xm2 = 0.f, xm1 = 0.f;
        if (!first) { xm3 = bf2f(zx[(size_t)(row0 - 3) * 2048]); xm2 = bf2f(zx[(size_t)(row0 - 2) * 2048]); xm1 = bf2f(zx[(size_t)(row0 - 1) * 2048]); }
        float hl = 0.f, P = 1.f;
        unsigned short nx[16];
#pragma unroll
        for (int i = 0; i < 16; ++i) nx[i] = zx[(size_t)(row0 + i) * 2048];
#pragma unroll 1
        for (int sc = 0; sc < 8; ++sc) {
            float xc[16];
#pragma unroll
            for (int i = 0; i < 16; ++i) { const float x = bf2f(nx[i]); xc[i] = cb + cw0 * xm3 + cw1 * xm2 + cw2 * xm1 + cw3 * x; xm3 = xm2; xm2 = xm1; xm1 = x;
                xcl[i * 72 + lane] = (bf16)f2bf(xc[i]); }
            if (sc < 7) {
#pragma unroll
                for (int i = 0; i < 16; ++i) nx[i] = zx[(size_t)(row0 + 16 * (sc + 1) + i) * 2048]; }
            LDS_WAIT(); asm volatile("" ::: "memory");
            f32x4 acc[8];
#pragma unroll
            for (int et = 0; et < 8; ++et) acc[et] = (f32x4){0.f, 0.f, 0.f, 0.f};
#pragma unroll
            for (int ks = 0; ks < 2; ++ks) { const bf16x8 af = *(const LAS bf16x8*)(xcl + fr * 72 + ks * 32 + 8 * fq);
#pragma unroll
                for (int et = 0; et < 8; ++et) acc[et] = __builtin_amdgcn_mfma_f32_16x16x32_bf16(af, gB[et][ks], acc[et], 0, 0, 0); }
#pragma unroll
            for (int et = 0; et < 8; ++et)
#pragma unroll
                for (int r = 0; r < 4; ++r) gl[(4 * fq + r) * 132 + et * 16 + fr] = acc[et][r];
            LDS_WAIT(); asm volatile("" ::: "memory");
#pragma unroll
            for (int i = 0; i < 16; ++i) {
                const float r = fsig(gl[i * 132 + lane] + gbr), ig = fsig(gl[i * 132 + 64 + lane] + gbi);
                const float la = c8 * r, av = __expf(la), mult = sqrtf(-expm1f(2.0f * la));
                hl = av * hl + mult * ig * xc[i]; P *= av;
                const size_t row = (size_t)(row0 + 16 * sc + i);
                HL[row * 512 + ch] = hl; PC[row * 512 + ch] = (bf16)f2bf(P);
            }
            LDS_WAIT(); asm volatile("" ::: "memory");
        }
        SUMM[((size_t)ci * 512 + ch) * 2] = P; SUMM[((size_t)ci * 512 + ch) * 2 + 1] = hl;
    }
    {
        float bw[31];
#pragma unroll
        for (int k = 0; k < 31; ++k) bw[k] = a.in[I_BCW][k * 512 + ch];
        const float bb = a.in[I_BCB][ch], ng = a.in[I_BNG][ch], nb = a.in[I_BNB][ch];
        const bf16* zv = Z + 1024 + ch; const bf16* zg = Z + 1536 + ch;
        float win[32];
        win[0] = 0.f; win[1] = 0.f;
#pragma unroll
        for (int j = 2; j < 32; ++j) { float v = 0.f; if (!first) { const size_t row = (size_t)(row0 - 32 + j); v = bf2f(zv[row * 2048]) * fsig(bf2f(zg[row * 2048])); } win[j] = v; }
#pragma unroll 1
        for (int base = 0; base < 128; base += 32) {
#pragma unroll
            for (int j = 0; j < 32; ++j) { const size_t row = (size_t)(row0 + base + j);
                win[j] = bf2f(zv[row * 2048]) * fsig(bf2f(zg[row * 2048]));
                float acc = bb;
#pragma unroll
                for (int k = 0; k < 31; ++k) acc += bw[k] * win[(j + 2 + k) & 31];
                const float mean = wave_sum(acc) * (1.0f / 64.0f), dlt = acc - mean;
                const float var = wave_sum(dlt * dlt) * (1.0f / 64.0f);
                const float y = dlt * rsqrtf(var + EPS) * ng + nb;
                YCAT[row * 1024 + 512 + ch] = (bf16)f2bf(y * fsig(y)); }
        }
    }
}

__device__ __forceinline__ void m3_chunk(unsigned char* ws, LAS unsigned char* lds, int ci, int tid_) {
    int tid = tid_; asm volatile("" : "+v"(tid));
    const bf16* Z = (const bf16*)(ws + WS_ACT);
    const float* HL = (const float*)(ws + WS_Y); const bf16* PC = (const bf16*)(ws + WS_PC); const float* SUMM = (const float*)(ws + WS_SUMM); bf16* YCAT = (bf16*)(ws + WS_XN);
    LAS float* cl = (LAS float*)lds;
    const int c0 = (ci / (SEQ / 128)) * (SEQ / 128);
    float carry = 0.f;
    for (int c = c0; c < ci; ++c) { const pg8::f32x2 s = *(const pg8::f32x2*)(SUMM + ((size_t)c * 512 + tid) * 2); carry = s.x * carry + s.y; }
    cl[tid] = carry;
    __syncthreads();
    const int c4 = (tid & 127) * 4; const f32x4 cr = *(const LAS f32x4*)(cl + c4);
#pragma unroll 4
    for (int p = 0; p < 32; ++p) { const size_t row = (size_t)(ci * 128 + p * 4 + (tid >> 7));
        const f32x4 hl = *(const f32x4*)(HL + row * 512 + c4); const u32x2 pc = *(const u32x2*)(PC + row * 512 + c4); const u32x2 ag = *(const u32x2*)(Z + row * 2048 + c4);
        const f32x4 pv = (f32x4){bflo(pc.x), bfhi(pc.x), bflo(pc.y), bfhi(pc.y)}, av = (f32x4){bflo(ag.x), bfhi(ag.x), bflo(ag.y), bfhi(ag.y)};
        const f32x4 h = hl + pv * cr;
        u32x2 o; o.x = pg8::cvt_pk_bf16(h.x * gelu_t(av.x), h.y * gelu_t(av.y)); o.y = pg8::cvt_pk_bf16(h.z * gelu_t(av.z), h.w * gelu_t(av.w));
        *(u32x2*)(YCAT + row * 1024 + c4) = o; }
    __syncthreads();
}

__device__ __forceinline__ void sg_chunk(const Args& a, unsigned char* ws, LAS unsigned char* lds, int ci, int w, int lane_, int tid_) {
    int lane = lane_, tid = tid_; asm volatile("" : "+v"(lane), "+v"(tid));
    const bf16* Z = (const bf16*)(ws + WS_ACT); bf16* UG = (bf16*)(ws + WS_XN); const bf16* WSB = (const bf16*)(ws + WS_WSB);
    const float* S1 = (const float*)(ws + WS_ST1); const float* S2 = (const float*)(ws + WS_ST2);
    LAS float* sm = (LAS float*)lds;
    LAS bf16* vT = (LAS bf16*)(lds + 1024 + w * 17408);
    const int row0 = ci * 128;
    if (tid < 128) { const size_t row = (size_t)(row0 + tid); float s1 = 0.f, s2 = 0.f;
#pragma unroll
        for (int i = 0; i < 4; ++i) { const f32x4 p = *(const f32x4*)(S1 + row * 16 + 4 * i), q = *(const f32x4*)(S2 + row * 16 + 4 * i); s1 += (p.x + p.y) + (p.z + p.w); s2 += (q.x + q.y) + (q.z + q.w); }
        const float mean = s1 * (1.0f / 1024.0f), var = s2 * (1.0f / 1024.0f) - mean * mean;
        sm[2 * tid] = mean; sm[2 * tid + 1] = rsqrtf(var + EPS); }
    __syncthreads();
    const int fr = lane & 15, fq = lane >> 4;
#pragma unroll 1
    for (int hh = 0; hh < 2; ++hh) {
        const int cbase = w * 128 + hh * 64;
        { const int csub = (lane & 7) * 8, sl = lane >> 3;
            float g8[8], b8[8];
#pragma unroll
            for (int e = 0; e < 8; ++e) { g8[e] = a.in[I_CNG][cbase + csub + e]; b8[e] = a.in[I_CNB][cbase + csub + e]; }
#pragma unroll 4
            for (int i = 0; i < 16; ++i) { const int s = sl + 8 * i; const v4u raw = *(const v4u*)(Z + (size_t)(row0 + s) * 2048 + 1024 + cbase + csub);
                const float mean = sm[2 * s], rstd = sm[2 * s + 1];
                const unsigned rw[4] = {raw.x, raw.y, raw.z, raw.w};
#pragma unroll
                for (int e = 0; e < 8; ++e) { const float v = (e & 1) ? bfhi(rw[e >> 1]) : bflo(rw[e >> 1]);
                    vT[(csub + e) * 136 + s] = (bf16)f2bf((v - mean) * rstd * g8[e] + b8[e]); } }
        }
        LDS_WAIT(); asm volatile("" ::: "memory");
#pragma unroll
        for (int tt = 0; tt < 8; ++tt) {
            f32x4 acc[4];
#pragma unroll
            for (int ct = 0; ct < 4; ++ct) acc[ct] = (f32x4){0.f, 0.f, 0.f, 0.f};
#pragma unroll
            for (int ks = 0; ks < tt / 2 + 1; ++ks) {
                const bf16x8 yf = *(const bf16x8*)(WSB + ((size_t)w * 128 + tt * 16 + fr) * 128 + ks * 32 + 8 * fq);
#pragma unroll
                for (int ct = 0; ct < 4; ++ct) { const bf16x8 xf = *(const LAS bf16x8*)(vT + (ct * 16 + fr) * 136 + ks * 32 + 8 * fq);
                    acc[ct] = __builtin_amdgcn_mfma_f32_16x16x32_bf16(xf, yf, acc[ct], 0, 0, 0); }
            }
            const int t = tt * 16 + fr; const size_t row = (size_t)(row0 + t); const float bs = a.in[I_CBS][w * 128 + t];
#pragma unroll
            for (int ct = 0; ct < 4; ++ct) { const int cc = cbase + ct * 16 + 4 * fq; const u32x2 uu = *(const u32x2*)(Z + row * 2048 + cc);
                u32x2 o; o.x = pg8::cvt_pk_bf16(bflo(uu.x) * (acc[ct][0] + bs), bfhi(uu.x) * (acc[ct][1] + bs)); o.y = pg8::cvt_pk_bf16(bflo(uu.y) * (acc[ct][2] + bs), bfhi(uu.y) * (acc[ct][3] + bs));
                *(u32x2*)(UG + row * 1024 + cc) = o; }
        }
        LDS_WAIT(); asm volatile("" ::: "memory");
    }
    __syncthreads();
}

__global__ void __launch_bounds__(NTHR, 2) mega_fwd(Args args) {
    extern __shared__ __attribute__((aligned(16))) unsigned char lds_raw[];
    LAS unsigned char* lds = (LAS unsigned char*)lds_raw;
    volatile LAS unsigned* MISC = (volatile LAS unsigned*)(lds + MISC_OFF);
    const int tid = threadIdx.x, lane = tid & 63, wave = __builtin_amdgcn_readfirstlane(tid >> 6);
    const int G = gridDim.x, bx = blockIdx.x;
    const int gw = bx * NWAVES + wave, NGW = G * NWAVES;
    unsigned char* ws = args.ws;
    gu32* ctl = (gu32*)(ws + WS_CTL);
    for (int u = tid; u < (LDS_BYTES - LDSCTL_OFF) / 4; u += NTHR) ((LAS unsigned*)(lds + LDSCTL_OFF))[u] = 0u;
    __syncthreads();
    XcdBarrier bar = xcd_barrier_post((unsigned*)(ctl + CW_BAR), MISC + 8);
#define GRID_BAR() xcd_barrier(bar)

    float* PAR = (float*)(ws + WS_PAR);
    bf16* XN = (bf16*)(ws + WS_XN); bf16* ACT = (bf16*)(ws + WS_ACT); bf16* YB = (bf16*)(ws + WS_Y);
    float* ST0 = (float*)(ws + WS_ST0); float* ST1 = (float*)(ws + WS_ST1); float* ST2 = (float*)(ws + WS_ST2);
#define PARP(l, s, q) (PAR + ((size_t)((l) * 3 + (s)) * 2) * 3072 + (q) * 1024)

    {
        LAS float* scr = (LAS float*)(lds + wave * 16384);
        constexpr int I13 = (D / 64) * (2 * FF / 32), I2 = (FF / 64) * (D / 32), IWIN = (D / 64) * (2048 / 32), IWOUT = (D / 64) * (D / 32);
        constexpr int NITEMS = 4 * I13 + 4 * I2 + 2 * IWIN + 2 * IWOUT;
        for (int it = gw; it < NITEMS; it += NGW) {
            int r = it;
            if (r < 4 * I13) { const int mi = r / I13; r -= mi * I13; p0_transpose_item(args.in[I_W13] + (size_t)mi * D * 2 * FF, D, 2 * FF, (bf16*)(ws + WS_W + (size_t)(mi >> 1) * LAYER_W_BYTES + LW_W13 + (size_t)(mi & 1) * W13_BYTES), 1, scr, r, lane); continue; } r -= 4 * I13;
            if (r < 4 * I2) { const int mi = r / I2; r -= mi * I2; p0_transpose_item(args.in[I_W2] + (size_t)mi * FF * D, FF, D, (bf16*)(ws + WS_W + (size_t)(mi >> 1) * LAYER_W_BYTES + LW_W2 + (size_t)(mi & 1) * W2_BYTES), 0, scr, r, lane); continue; } r -= 4 * I2;
            if (r < IWIN) { p0_transpose_item(args.in[I_ABWIN], D, 2048, (bf16*)(ws + WS_W + LW_WIN), 0, scr, r, lane); continue; } r -= IWIN;
            if (r < IWIN) { p0_transpose_item(args.in[I_CWIN], D, 2048, (bf16*)(ws + WS_W + LAYER_W_BYTES + LW_WIN), 0, scr, r, lane); continue; } r -= IWIN;
            if (r < IWOUT) { p0_transpose_item(args.in[I_ABWOUT], D, D, (bf16*)(ws + WS_W + LW_WOUT), 0, scr, r, lane); continue; } r -= IWOUT;
            p0_transpose_item(args.in[I_CWOUT], D, D, (bf16*)(ws + WS_W + LAYER_W_BYTES + LW_WOUT), 0, scr, r, lane);
        }
        { bf16* WSB = (bf16*)(ws + WS_WSB); const float* wsp = args.in[I_CWS];
            for (int e = bx * NTHR + tid; e < 8 * 128 * 128; e += G * NTHR) { const int s = e & 127, t = (e >> 7) & 127; WSB[e] = (bf16)f2bf(s <= t ? wsp[e] : 0.f); } }
        { bf16* GWT = (bf16*)(ws + WS_GWT); const float* gp = args.in[I_AGW];
            for (int e = bx * NTHR + tid; e < 8 * 128 * 64; e += G * NTHR) { const int d = e & 63, ee = (e >> 6) & 127, h = e >> 13; GWT[e] = (bf16)f2bf(gp[((size_t)h * 64 + d) * 128 + ee]); } }
        { float* MODP = (float*)(ws + WS_MODP); const float* cp = args.in[I_C];
            for (int it = gw; it < 2 * 36 * 32; it += NGW) { const int l = it / 1152, rem = it % 1152, jb = rem / 32, kw = rem % 32;
                const float* wp = args.in[I_ADAW] + ((size_t)l * 1024 + kw * 32) * 9216 + jb * 256 + 4 * lane;
                f32x4 a0 = (f32x4){0.f, 0.f, 0.f, 0.f}, a1 = a0;
#pragma unroll 8
                for (int k = 0; k < 32; ++k) { const f32x4 wv = *(const f32x4*)(wp + (size_t)k * 9216);
                    const float c0 = cp[kw * 32 + k], c1 = cp[1024 + kw * 32 + k];
                    const float s0 = c0 / (1.0f + expf(-c0)), s1 = c1 / (1.0f + expf(-c1));
                    a0 = a0 + wv * s0; a1 = a1 + wv * s1; }
                *(f32x4*)(MODP + ((size_t)(kw * 2 + l) * 2 + 0) * 9216 + jb * 256 + 4 * lane) = a0;
                *(f32x4*)(MODP + ((size_t)(kw * 2 + l) * 2 + 1) * 9216 + jb * 256 + 4 * lane) = a1; } }
    }
    asm volatile("s_waitcnt vmcnt(0)" ::: "memory");
    __threadfence();
    cg::this_grid().sync();
    GRID_BAR();
    {
        const float* MODP = (const float*)(ws + WS_MODP);
        for (int t = bx * NTHR + tid; t < 2 * 3 * 2 * 1024; t += G * NTHR) {
            const int c = t & 1023, b = (t >> 10) & 1, ls = t >> 11, l = ls / 3, s = ls % 3;
            float v[3];
#pragma unroll
            for (int q = 0; q < 3; ++q) { const int j = s * 3072 + q * 1024 + c; float acc = args.in[I_ADAB][l * 9216 + j];
                for (int kw = 0; kw < 32; ++kw) acc += MODP[((size_t)(kw * 2 + l) * 2 + b) * 9216 + j];
                v[q] = acc; }
            const float resw = (s == 1) ? 1.0f : 0.5f;
            float* p = PAR + ((size_t)(l * 3 + s) * 2 + b) * 3072 + c;
            p[0] = resw * (1.0f + v[2]) * args.in[I_NPOST][(l * 3 + s) * 1024 + c];
            p[1024] = args.in[I_NPRE][(l * 3 + s) * 1024 + c] * (1.0f + v[1]);
            p[2048] = v[0];
        }
    }
    GRID_BAR();
    trans_phase<false, true>(gw, NGW, lane, args.in[I_X], nullptr, nullptr, nullptr, nullptr, PARP(0, 0, 1), PARP(0, 0, 2), XN);
    GRID_BAR();

#pragma unroll 1
    for (int l = 0; l < 2; ++l) {
        unsigned char* wl = ws + WS_W + (size_t)l * LAYER_W_BYTES;
#pragma unroll 1
        for (int s = 0; s < 3; ++s) {
            if (s != 1) {
                const int fi = s >> 1;
                { pg8::Gemm g{XN, (const bf16*)(wl + LW_W13 + (size_t)fi * W13_BYTES), M, 2 * FF, D}; pg8::StaticOrder S; S.init(M, 2 * FF, G, bx);
                    pg8::EpiX<1> E{ACT, FF, nullptr, nullptr, nullptr};
                    pg8::gemm_phase<pg8::EpiX<1>, pg8::StaticOrder, true, true>(lds, g, S, E); }
                GRID_BAR();
                { pg8::Gemm g{ACT, (const bf16*)(wl + LW_W2 + (size_t)fi * W2_BYTES), M, D, FF}; pg8::StaticOrder S; S.init(M, D, G, bx);
                    pg8::EpiX<2> E{YB, D, nullptr, ST0, nullptr};
                    pg8::gemm_phase<pg8::EpiX<2>, pg8::StaticOrder, true, true>(lds, g, S, E); }
                GRID_BAR();
            } else if (l == 0) {
                { pg8::Gemm g{XN, (const bf16*)(wl + LW_WIN), M, 2048, D}; pg8::StaticOrder S; S.init(M, 2048, G, bx);
                    pg8::EpiX<0> E{ACT, 2048, nullptr, nullptr, nullptr};
                    pg8::gemm_phase<pg8::EpiX<0>, pg8::StaticOrder, true, true>(lds, g, S, E); }
                GRID_BAR();
                for (int ci = bx; ci < NCHUNK; ci += G) m1_chunk(args, ws, lds, ci, wave, lane);
                GRID_BAR();
                for (int ci = bx; ci < NCHUNK; ci += G) m3_chunk(ws, lds, ci, tid);
                GRID_BAR();
                { pg8::Gemm g{XN, (const bf16*)(wl + LW_WOUT), M, D, D}; pg8::StaticOrder S; S.init(M, D, G, bx);
                    pg8::EpiX<2> E{YB, D, nullptr, ST0, nullptr};
                    pg8::gemm_phase<pg8::EpiX<2>, pg8::StaticOrder, true, true>(lds, g, S, E); }
                GRID_BAR();
            } else {
                { pg8::Gemm g{XN, (const bf16*)(wl + LW_WIN), M, 2048, D}; pg8::StaticOrder S; S.init(M, 2048, G, bx);
                    pg8::EpiX<3> E{ACT, 2048, args.in[I_CBIN], ST1, ST2};
                    pg8::gemm_phase<pg8::EpiX<3>, pg8::StaticOrder, true, true>(lds, g, S, E); }
                GRID_BAR();
                for (int ci = bx; ci < NCHUNK; ci += G) sg_chunk(args, ws, lds, ci, wave, lane, tid);
                GRID_BAR();
                { pg8::Gemm g{XN, (const bf16*)(wl + LW_WOUT), M, D, D}; pg8::StaticOrder S; S.init(M, D, G, bx);
                    pg8::EpiX<2> E{YB, D, nullptr, ST0, nullptr};
                    pg8::gemm_phase<pg8::EpiX<2>, pg8::StaticOrder, true, true>(lds, g, S, E); }
                GRID_BAR();
            }
            const float* xin = (l == 0 && s == 0) ? args.in[I_X] : args.out;
            if (l == 1 && s == 2) trans_phase<true, false>(gw, NGW, lane, xin, args.out, YB, ST0, PARP(l, s, 0), nullptr, nullptr, nullptr);
            else { const int nl = (s == 2) ? l + 1 : l, ns = (s == 2) ? 0 : s + 1;
                trans_phase<true, true>(gw, NGW, lane, xin, args.out, YB, ST0, PARP(l, s, 0), PARP(nl, ns, 1), PARP(nl, ns, 2), XN);
                GRID_BAR(); }
        }
    }
}

extern "C" void kernel_launch(void* const* d_in, const int* in_sizes, int n_in, void* d_out, int out_size, void* d_ws, size_t ws_size, hipStream_t stream) {
    static int grid = 0;
    if (grid == 0) {
        if (n_in != 26 || in_sizes[0] != M * D || out_size != M * D || ws_size < WS_END) { fprintf(stderr, "kernel_launch: unexpected shapes (n_in %d, in0 %d, out %d, ws %zu)\n", n_in, n_in > 0 ? in_sizes[0] : -1, out_size, ws_size); grid = -1; return; }
        int dev = 0, cus = 0, per_cu = 0;
        if (hipGetDevice(&dev) != hipSuccess || hipDeviceGetAttribute(&cus, hipDeviceAttributeMultiprocessorCount, dev) != hipSuccess) { grid = -1; return; }
        if (hipFuncSetAttribute((const void*)mega_fwd, hipFuncAttributeMaxDynamicSharedMemorySize, LDS_BYTES) != hipSuccess) { fprintf(stderr, "kernel_launch: hipFuncSetAttribute failed\n"); grid = -1; return; }
        if (hipOccupancyMaxActiveBlocksPerMultiprocessor(&per_cu, (const void*)mega_fwd, NTHR, LDS_BYTES) != hipSuccess || per_cu < 1) { fprintf(stderr, "kernel_launch: occupancy query says %d\n", per_cu); per_cu = 1; }
        (void)hipGetLastError();
        grid = cus;
    }
    if (grid < 0) return;
    (void)hipMemsetAsync((char*)d_ws + WS_CTL, 0, CTL_ZERO_BYTES, stream);
    Args a{};
    for (int i = 0; i < 26; ++i) a.in[i] = (const float*)d_in[i];
    a.out = (float*)d_out; a.ws = (unsigned char*)d_ws;
    void* kargs[] = {&a};
    const hipError_t le = hipLaunchCooperativeKernel((const void*)mega_fwd, dim3(grid), dim3(NTHR), kargs, LDS_BYTES, stream);
    if (le != hipSuccess) fprintf(stderr, "kernel_launch: cooperative launch failed: %s (grid %d)\n", hipGetErrorName(le), grid);
}
```

```cpp
#include <hip/hip_runtime.h>
#include <hip/hip_cooperative_groups.h>
#include <cstdio>
#include <cstdint>
namespace cg = cooperative_groups;
namespace pg8 {
#define PG8_LAS __attribute__((address_space(3)))
typedef unsigned short bf16_t;
typedef short bf16x8 __attribute__((ext_vector_type(8)));
typedef float f32x4 __attribute__((ext_vector_type(4)));
typedef unsigned u32x4 __attribute__((ext_vector_type(4)));
constexpr int BM = 256, BK = 64, HALF = 128, HTB = HALF * BK * 2  , STAGE_BYTES = 8 * HTB, NXCD = 8, WGM = 8;

__host__ __device__ __forceinline__ int lds_byte(int r, int c) { const int st = (r >> 4) * 2 + (c >> 5), rr = r & 15, cc = c & 31, ob = rr * 64 + cc * 2; return st * 1024 + (ob ^ (((ob >> 9) & 1) << 5)); }
__host__ __device__ __forceinline__ void stage_rc(int b, int& R, int& C) { const int st = b / 1024, sb = b % 1024, swz = sb ^ (((sb >> 9) & 1) << 5); R = (st >> 1) * 16 + swz / 64; C = (st & 1) * 32 + (swz % 64) / 2; }
__host__ __device__ __forceinline__ int perm32(int rho) { const int n = rho >> 4, i = rho & 15; return 8 * (i >> 2) + 4 * n + (i & 3); }

struct Unit { int pm, pn; };
struct Gemm { const bf16_t* A; const bf16_t* Bt; int M, N, K; };

struct StaticOrder {
    int nM, nN, nwg, G, c;
    __host__ __device__ void init(int M, int N, int G_, int c_) { nM = M / BM; nN = N / BM; nwg = nM * nN; G = G_; c = c_; }
    __host__ __device__ bool next(int i, Unit& u) const {
        const long L = (long)i * G + c; if (L >= nwg) return false;
        int wgid = (int)L; { const int q = nwg / NXCD, r = nwg % NXCD, xcd = wgid % NXCD, off = wgid / NXCD; wgid = (xcd < r ? xcd * (q + 1) : r * (q + 1) + (xcd - r) * q) + off; }
        const int nig = WGM * nN, gid = wgid / nig, fm = gid * WGM, gsz = (nM - fm) < WGM ? (nM - fm) : WGM;
        u.pm = fm + ((wgid % nig) % gsz); u.pn = (wgid % nig) / gsz; return true;
    }
    __device__ __forceinline__ void a_ready(const Unit&) const {}
    __device__ __forceinline__ void done(const Unit&) const {}
};

__device__ __forceinline__ unsigned cvt_pk_bf16(float lo, float hi) { unsigned r; asm volatile("v_cvt_pk_bf16_f32 %0, %1, %2" : "=v"(r) : "v"(lo), "v"(hi)); return r; }
typedef float f32x2 __attribute__((ext_vector_type(2)));
__device__ __forceinline__ float fast_sigmoid(float x) { return __builtin_amdgcn_rcpf(1.0f + __expf(-x)); }
__device__ __forceinline__ float gelu_tanh(float x) { const float u = 1.5957691216f * (x + 0.044715f * x * x * x); return x * fast_sigmoid(u); }
template <int MODE> struct EpiX {
    static constexpr bool PERM = true, AFTER_DRAIN = false;
    bf16_t* O; int ldc; const float* bias; float* st0; float* st1;
    __device__ __forceinline__ void operator()(const f32x4 (&acc)[2][2][4][2], const Unit& u, int wr, int wc, int fr, int fq) const {
        const int row0 = u.pm * BM + wr * 64 + fr;
        if constexpr (MODE == 1) {
            const int col0 = u.pn * HALF + wc * 32 + 8 * fq;
#pragma unroll
            for (int ai = 0; ai < 2; ++ai)
#pragma unroll
                for (int m = 0; m < 4; ++m) { bf16_t* rowp = O + (size_t)(row0 + ai * HALF + m * 16) * ldc + col0;
                    const f32x4 g0 = acc[ai][0][m][0], g1 = acc[ai][0][m][1], u0 = acc[ai][1][m][0], u1 = acc[ai][1][m][1];
                    float r[8];
#pragma unroll
                    for (int e = 0; e < 4; ++e) {
                        r[e] = g0[e] * u0[e] * __builtin_amdgcn_rcpf(1.0f + __builtin_amdgcn_exp2f(-g0[e])); r[4 + e] = g1[e] * u1[e] * __builtin_amdgcn_rcpf(1.0f + __builtin_amdgcn_exp2f(-g1[e])); }
                    u32x4 w; w.x = cvt_pk_bf16(r[0], r[1]); w.y = cvt_pk_bf16(r[2], r[3]); w.z = cvt_pk_bf16(r[4], r[5]); w.w = cvt_pk_bf16(r[6], r[7]);
                    *(u32x4*)rowp = w; }
        } else {
            const int col0 = u.pn * BM + wc * 32 + 8 * fq;
            f32x4 bv[2][2];
#pragma unroll
            for (int bj = 0; bj < 2; ++bj)
#pragma unroll
                for (int n = 0; n < 2; ++n) bv[bj][n] = (MODE == 3) ? *(const f32x4*)(bias + col0 + bj * HALF + 4 * n) : (f32x4){0.f, 0.f, 0.f, 0.f};
#pragma unroll
            for (int ai = 0; ai < 2; ++ai)
#pragma unroll
                for (int m = 0; m < 4; ++m) { const int row = row0 + ai * HALF + m * 16; bf16_t* rowp = O + (size_t)row * ldc + col0;
                    float s1 = 0.f, s2 = 0.f;
#pragma unroll
                    for (int bj = 0; bj < 2; ++bj) { f32x4 v0 = acc[ai][bj][m][0], v1 = acc[ai][bj][m][1];
                        if constexpr (MODE == 3) { v0 = v0 + bv[bj][0]; v1 = v1 + bv[bj][1];
#pragma unroll
                            for (int e = 0; e < 4; ++e) { v0[e] = gelu_tanh(v0[e]); v1[e] = gelu_tanh(v1[e]); } }
                        if constexpr (MODE == 2 || MODE == 3) {
#pragma unroll
                            for (int e = 0; e < 4; ++e) { s1 += v0[e] + v1[e]; s2 += v0[e] * v0[e] + v1[e] * v1[e]; } }
                        u32x4 w; w.x = cvt_pk_bf16(v0[0], v0[1]); w.y = cvt_pk_bf16(v0[2], v0[3]); w.z = cvt_pk_bf16(v1[0], v1[1]); w.w = cvt_pk_bf16(v1[2], v1[3]);
                        *(u32x4*)(rowp + bj * HALF) = w; }
                    if constexpr (MODE == 2) { s2 += __shfl_xor(s2, 16); s2 += __shfl_xor(s2, 32); if (fq == 0) st0[(size_t)row * 16 + u.pn * 4 + wc] = s2; }
                    if constexpr (MODE == 3) { if (u.pn >= 4) { s1 += __shfl_xor(s1, 16); s1 += __shfl_xor(s1, 32); s2 += __shfl_xor(s2, 16); s2 += __shfl_xor(s2, 32);
                            if (fq == 0) { st0[(size_t)row * 16 + (u.pn - 4) * 4 + wc] = s1; st1[(size_t)row * 16 + (u.pn - 4) * 4 + wc] = s2; } } }
                }
        }
    }
};
template <class Epi, class Sched, bool ALIGN_EPI = false, bool SP2 = false>
__device__ __forceinline__ void gemm_phase(PG8_LAS unsigned char* lds, const Gemm g, const Sched& S, const Epi& E) {
    int tid_ = threadIdx.x; asm volatile("" : "+v"(tid_));
    const int tid = tid_, wid = __builtin_amdgcn_readfirstlane(tid >> 6), lane = tid & 63, wr = wid >> 2, wc = wid & 3, fr = lane & 15, fq = lane >> 4;
    const int K = g.K, nt = K / BK;
    unsigned voffA[2], voffB[2];
#pragma unroll
    for (int i = 0; i < 2; ++i) { int R, C; stage_rc(tid * 16 + i * 8192, R, C); const int Rb = Epi::PERM ? ((R & ~31) + perm32(R & 31)) : R;
        voffA[i] = (unsigned)(R * K + C) * 2u; voffB[i] = (unsigned)(Rb * K + C) * 2u; }
    const size_t kstep = (size_t)(BK * 2);
    const size_t hstep = (size_t)HALF * K * 2;
    const size_t tstep = 2 * hstep;
    const unsigned ldsw = (unsigned)wid * 1024u;
    const int aoff = lds_byte(wr * 64 + fr, fq * 8), boff = lds_byte(wc * 32 + fr, fq * 8);
#define PG8_SA(b, h) (((b) * 2 + (h)) * HTB)
#define PG8_SB(b, h) ((4 + (b) * 2 + (h)) * HTB)
#define PG8_STAGE(bufoff, gbase, voff) do { _Pragma("unroll") for (int _i = 0; _i < 2; ++_i) \
        __builtin_amdgcn_global_load_lds((const unsigned*)((const char*)(gbase) + (voff)[_i]), (PG8_LAS unsigned*)(lds + (bufoff) + ldsw + _i * 8192), 16, 0, 0); } while (0)
#define PG8_LDA(dst, b, h) do { _Pragma("unroll") for (int m = 0; m < 4; ++m) _Pragma("unroll") for (int k = 0; k < 2; ++k) dst[m][k] = *(const PG8_LAS bf16x8*)(lds + PG8_SA(b, h) + aoff + m * 2048 + k * 1024); } while (0)
#define PG8_LDB(dst, b, h) do { _Pragma("unroll") for (int n = 0; n < 2; ++n) _Pragma("unroll") for (int k = 0; k < 2; ++k) dst[n][k] = *(const PG8_LAS bf16x8*)(lds + PG8_SB(b, h) + boff + n * 2048 + k * 1024); } while (0)
#define PG8_MMA(ai, bj, At, Bt) do { __builtin_amdgcn_s_setprio(1); _Pragma("unroll") for (int m = 0; m < 4; ++m) _Pragma("unroll") for (int n = 0; n < 2; ++n) _Pragma("unroll") for (int k = 0; k < 2; ++k) \
        acc[ai][bj][m][n] = __builtin_amdgcn_mfma_f32_16x16x32_bf16(Bt[n][k], At[m][k], acc[ai][bj][m][n], 0, 0, 0); __builtin_amdgcn_s_setprio(0); } while (0)
#define PG8_WAIT_V(n) asm volatile("s_waitcnt vmcnt(" #n ")" ::: "memory")
#define PG8_WAIT_L(n) asm volatile("s_waitcnt lgkmcnt(" #n ")" ::: "memory")
#define PG8_BAR __builtin_amdgcn_s_barrier()
#define PG8_SCHED __builtin_amdgcn_sched_barrier(0)
    Unit cur, nxt; int ui = 0;
    if (!S.next(0, cur)) return;
    f32x4 acc[2][2][4][2];
#pragma unroll
    for (int a = 0; a < 2; ++a)
#pragma unroll
        for (int b = 0; b < 2; ++b)
#pragma unroll
            for (int m = 0; m < 4; ++m)
#pragma unroll
                for (int n = 0; n < 2; ++n) acc[a][b][m][n] = (f32x4){0.f, 0.f, 0.f, 0.f};
    bf16x8 At[4][2], B0[2][2], B1[2][2];
    const char* cA = (const char*)g.A + (size_t)cur.pm * tstep; const char* cB = (const char*)g.Bt + (size_t)cur.pn * tstep;
    S.a_ready(cur);
    if constexpr (SP2) {
        PG8_STAGE(PG8_SB(0, 0), cB, voffB); PG8_STAGE(PG8_SB(0, 1), cB + hstep, voffB); PG8_STAGE(PG8_SA(0, 0), cA, voffA); PG8_STAGE(PG8_SA(0, 1), cA + hstep, voffA);
        if (wr == 1) PG8_BAR;
        PG8_WAIT_V(2); PG8_BAR;
        PG8_STAGE(PG8_SB(1, 0), cB + kstep, voffB); PG8_STAGE(PG8_SA(1, 0), cA + kstep, voffA); PG8_STAGE(PG8_SB(1, 1), cB + hstep + kstep, voffB);
        PG8_WAIT_V(6); PG8_BAR;
    } else {
        PG8_STAGE(PG8_SB(0, 0), cB, voffB); PG8_STAGE(PG8_SA(0, 0), cA, voffA); PG8_STAGE(PG8_SB(0, 1), cB + hstep, voffB); PG8_STAGE(PG8_SA(0, 1), cA + hstep, voffA);
        if (wr == 1) PG8_BAR;
        PG8_WAIT_V(4); PG8_BAR;
        PG8_STAGE(PG8_SB(1, 0), cB + kstep, voffB); PG8_STAGE(PG8_SA(1, 0), cA + kstep, voffA); PG8_STAGE(PG8_SB(1, 1), cB + hstep + kstep, voffB);
        PG8_WAIT_V(6); PG8_BAR;
    }
    for (;;) {
        const bool has_next = S.next(ui + 1, nxt);
        const char* nA = has_next ? (const char*)g.A + (size_t)nxt.pm * tstep : cA; const char* nB = has_next ? (const char*)g.Bt + (size_t)nxt.pn * tstep : cB;
        for (int t = 0; t < nt; t += 2) {
            const bool last = (t == nt - 2);
            const char* a1 = cA + (size_t)(t + 1) * kstep;
            const char* a2 = last ? nA : cA + (size_t)(t + 2) * kstep; const char* b2 = last ? nB : cB + (size_t)(t + 2) * kstep;
            const char* a3 = a2 + kstep; const char* b3 = b2 + kstep;
            if (last && has_next) S.a_ready(nxt);
            if constexpr (SP2) {
            PG8_LDB(B0, 0, 0); PG8_LDB(B1, 0, 1); PG8_SCHED; PG8_LDA(At, 0, 0); PG8_STAGE(PG8_SA(1, 1), a1 + hstep, voffA);
            PG8_WAIT_V(8); PG8_WAIT_L(0); PG8_BAR; PG8_MMA(0, 0, At, B0); PG8_MMA(0, 1, At, B1); PG8_BAR; PG8_SCHED;
            PG8_LDA(At, 0, 1); PG8_STAGE(PG8_SB(0, 0), b2, voffB); PG8_STAGE(PG8_SB(0, 1), b2 + hstep, voffB); PG8_STAGE(PG8_SA(0, 0), a2, voffA);
            PG8_WAIT_V(8); PG8_WAIT_L(0); PG8_BAR; PG8_MMA(1, 0, At, B0); PG8_MMA(1, 1, At, B1); PG8_BAR; PG8_SCHED;
            PG8_LDB(B0, 1, 0); PG8_LDB(B1, 1, 1); PG8_SCHED; PG8_LDA(At, 1, 0); PG8_STAGE(PG8_SA(0, 1), a2 + hstep, voffA);
            PG8_WAIT_V(8); PG8_WAIT_L(0); PG8_BAR; PG8_MMA(0, 0, At, B0); PG8_MMA(0, 1, At, B1); PG8_BAR; PG8_SCHED;
            PG8_LDA(At, 1, 1); PG8_STAGE(PG8_SB(1, 0), b3, voffB); PG8_STAGE(PG8_SB(1, 1), b3 + hstep, voffB); PG8_STAGE(PG8_SA(1, 0), a3, voffA);
            PG8_WAIT_V(8); PG8_WAIT_L(0); PG8_BAR; PG8_MMA(1, 0, At, B0); PG8_MMA(1, 1, At, B1); PG8_BAR; PG8_SCHED;
            } else {
            PG8_LDB(B0, 0, 0); PG8_SCHED; PG8_LDA(At, 0, 0); PG8_STAGE(PG8_SA(1, 1), a1 + hstep, voffA);
            PG8_WAIT_L(8); PG8_BAR; PG8_WAIT_L(0); PG8_MMA(0, 0, At, B0); PG8_BAR; PG8_SCHED;
            PG8_LDB(B1, 0, 1); PG8_STAGE(PG8_SB(0, 0), b2, voffB);
            PG8_BAR; PG8_WAIT_L(0); PG8_MMA(0, 1, At, B1); PG8_BAR;
            PG8_LDA(At, 0, 1); PG8_STAGE(PG8_SA(0, 0), a2, voffA);
            PG8_BAR; PG8_WAIT_L(0); PG8_MMA(1, 0, At, B0); PG8_BAR; PG8_SCHED;
            PG8_STAGE(PG8_SB(0, 1), b2 + hstep, voffB);
            PG8_WAIT_V(6); PG8_BAR; PG8_MMA(1, 1, At, B1); PG8_BAR;
            PG8_LDB(B0, 1, 0); PG8_SCHED; PG8_LDA(At, 1, 0); PG8_STAGE(PG8_SA(0, 1), a2 + hstep, voffA);
            PG8_WAIT_L(8); PG8_BAR; PG8_WAIT_L(0); PG8_MMA(0, 0, At, B0); PG8_BAR; PG8_SCHED;
            PG8_LDB(B1, 1, 1); PG8_STAGE(PG8_SB(1, 0), b3, voffB);
            PG8_BAR; PG8_WAIT_L(0); PG8_MMA(0, 1, At, B1); PG8_BAR;
            PG8_LDA(At, 1, 1); PG8_STAGE(PG8_SA(1, 0), a3, voffA);
            PG8_BAR; PG8_WAIT_L(0); PG8_MMA(1, 0, At, B0); PG8_BAR; PG8_SCHED;
            PG8_STAGE(PG8_SB(1, 1), b3 + hstep, voffB);
            PG8_WAIT_V(6); PG8_BAR; PG8_MMA(1, 1, At, B1); PG8_BAR;
            }
        }
        if constexpr (ALIGN_EPI) { if (wr == 0) PG8_BAR; }
        if constexpr (!Epi::AFTER_DRAIN) { E(acc, cur, wr, wc, fr, fq); S.done(cur); }
        if (!has_next) break;
#pragma unroll
        for (int a = 0; a < 2; ++a)
#pragma unroll
            for (int b = 0; b < 2; ++b)
#pragma unroll
                for (int m = 0; m < 4; ++m)
#pragma unroll
                    for (int n = 0; n < 2; ++n) acc[a][b][m][n] = (f32x4){0.f, 0.f, 0.f, 0.f};
        cur = nxt; cA = nA; cB = nB; ++ui;
        if constexpr (ALIGN_EPI) { if (wr == 1) PG8_BAR; }
    }
    PG8_WAIT_V(0);
    if constexpr (!ALIGN_EPI) { if (wr == 0) PG8_BAR; }
    PG8_BAR;
    if constexpr (Epi::AFTER_DRAIN) { E.fused(acc, cur, wr, wc, fr, fq, lds, wid, lane); S.done(cur); }
#undef PG8_SA
#undef PG8_SB
#undef PG8_STAGE
#undef PG8_LDA
#undef PG8_LDB
#undef PG8_MMA
#undef PG8_WAIT_V
#undef PG8_WAIT_L
#undef PG8_BAR
#undef PG8_SCHED
}
}
#define GAS __attribute__((address_space(1)))
#define LAS __attribute__((address_space(3)))
typedef unsigned short bf16;
typedef unsigned v4u __attribute__((ext_vector_type(4)));
typedef float f32x4 __attribute__((ext_vector_type(4)));
typedef short bf16x8 __attribute__((ext_vector_type(8)));
typedef GAS unsigned gu32;
typedef GAS unsigned long long gu64;
#define RLX_AGENT __ATOMIC_RELAXED, __HIP_MEMORY_SCOPE_AGENT
#define LDS_WAIT() asm volatile("s_waitcnt lgkmcnt(0)" ::: "memory")
#define VM_WAIT() asm volatile("s_waitcnt vmcnt(0)" ::: "memory")
__device__ __forceinline__ unsigned long long rt() { return __builtin_amdgcn_s_memrealtime(); }
__device__ __forceinline__ unsigned f2bf(float f) { unsigned u = __builtin_bit_cast(unsigned, f); return (u + 0x7fffu + ((u >> 16) & 1u)) >> 16; }
__device__ __forceinline__ unsigned pk2(float lo, float hi) { return f2bf(lo) | (f2bf(hi) << 16); }
#define XB_TMO      128
#define XB_XCNT(j)  (256  + 64 * (j))
#define XB_XSUB(j)  (1280 + 64 * (j))
#define XB_XGEN(j)  (2304 + 64 * (j))
#define XB_TOP      3328
#define XB_TOPGEN   3392
#define XCD_BAR_WORDS 3456
#define XB_SPIN_CAP (1u << 18)

__device__ __forceinline__ unsigned xb_ld(unsigned* p)              { return __hip_atomic_load(p, __ATOMIC_RELAXED, __HIP_MEMORY_SCOPE_AGENT); }
__device__ __forceinline__ unsigned xb_add(unsigned* p, unsigned v) { return __hip_atomic_fetch_add(p, v, __ATOMIC_RELAXED, __HIP_MEMORY_SCOPE_AGENT); }
__device__ __forceinline__ unsigned xb_xcc_id() { return (unsigned)__builtin_amdgcn_s_getreg((3 << 11) | 20) & 0xFu; }
#define XB_SPIN(cond, bar) do { unsigned _sp = 0; while (cond) { __builtin_amdgcn_s_sleep(1); \
    if ((++_sp & 255u) == 0u) { if (xb_ld(&(bar)[XB_TMO])) break; if (_sp > XB_SPIN_CAP) { atomicAdd(&(bar)[XB_TMO], 1u); break; } } } } while (0)

struct XcdBarrier {
    unsigned* bar; unsigned x;
    volatile LAS unsigned* st;
};

__device__ __forceinline__ XcdBarrier xcd_barrier_post(unsigned* bar, volatile LAS unsigned* st) {
    XcdBarrier b; b.bar = bar; b.x = xb_xcc_id(); b.st = st;
    if (threadIdx.x == 0) (void)xb_add(&bar[XB_XCNT(b.x)], 1u);
    return b;
}
__device__ __forceinline__ void xcd_barrier_complete(unsigned* bar, unsigned x, unsigned& nloc, unsigned& nx) {
    const unsigned G = gridDim.x * gridDim.y * gridDim.z;
    unsigned sum, cnt, mine, sp = 0u;
    for (;;) {
        sum = 0u; cnt = 0u; mine = 0u;
#pragma unroll
        for (unsigned j = 0; j < 16; ++j) { const unsigned c = xb_ld(&bar[XB_XCNT(j)]); sum += c; cnt += (c > 0u) ? 1u : 0u; mine = (j == x) ? c : mine; }
        if (sum == G) break;
        __builtin_amdgcn_s_sleep(1);
        if ((++sp & 255u) == 0u) { if (xb_ld(&bar[XB_TMO])) break; if (sp > XB_SPIN_CAP) { atomicAdd(&bar[XB_TMO], 1u); break; } }
    }
    nloc = mine > 0u ? mine : 1u; nx = cnt > 0u ? cnt : 1u;
}

__device__ __forceinline__ void xcd_barrier(const XcdBarrier& b) {
    asm volatile("s_waitcnt vmcnt(0)" ::: "memory");
    __syncthreads();
    if (threadIdx.x == 0) {
        unsigned* bar = b.bar;
        __builtin_amdgcn_s_waitcnt(0);
        unsigned nloc = b.st[0], nx = b.st[1];
        if (nloc == 0u) { xcd_barrier_complete(bar, b.x, nloc, nx); b.st[0] = nloc; b.st[1] = nx; }
        const unsigned old = xb_add(&bar[XB_XSUB(b.x)], 1u);
        const unsigned gen = old / nloc;
        if (old + 1u == (gen + 1u) * nloc) {
            __builtin_amdgcn_fence(__ATOMIC_RELEASE, "agent");
            asm volatile("s_waitcnt vmcnt(0)" ::: "memory");
            const unsigned og = xb_add(&bar[XB_TOP], 1u);
            const unsigned tg = og / nx;
            if (og + 1u == (tg + 1u) * nx) xb_add(&bar[XB_TOPGEN], 1u);
            else XB_SPIN(xb_ld(&bar[XB_TOPGEN]) == tg, bar);
            __builtin_amdgcn_fence(__ATOMIC_ACQUIRE, "agent");
            xb_add(&bar[XB_XGEN(b.x)], 1u);
            asm volatile("s_waitcnt vmcnt(0)" ::: "memory");
        } else {
            XB_SPIN(xb_ld(&bar[XB_XGEN(b.x)]) == gen, bar);
            __builtin_amdgcn_fence(__ATOMIC_ACQUIRE, "agent");
            asm volatile("s_waitcnt vmcnt(0)" ::: "memory");
        }
    }
    __syncthreads();
}

constexpr int NWAVES = 8, NTHR = NWAVES * 64;
constexpr int BATCH = 2, SEQ = 16384, D = 1024, FF = 2816, M = BATCH * SEQ;
constexpr int NCHUNK = M / 128;
constexpr float EPS = 1e-6f;
constexpr size_t MiB = 1u << 20;
constexpr size_t WS_CTL = 0, CTL_ZERO_BYTES = 1 * MiB;
constexpr size_t WS_W = 1 * MiB;
constexpr size_t W13_BYTES = (size_t)2 * FF * D * 2, W2_BYTES = (size_t)D * FF * 2, WIN_BYTES = (size_t)2048 * D * 2, WOUT_BYTES = (size_t)D * D * 2;
constexpr size_t LW_W13 = 0, LW_W2 = 2 * W13_BYTES, LW_WIN = LW_W2 + 2 * W2_BYTES, LW_WOUT = LW_WIN + WIN_BYTES, LAYER_W_BYTES = LW_WOUT + WOUT_BYTES;
static_assert(LAYER_W_BYTES == 39 * MiB, "weights");
constexpr size_t WS_XN = 80 * MiB;
constexpr size_t WS_ACT = 144 * MiB;
constexpr size_t WS_PC = WS_ACT + 128 * MiB;
constexpr size_t WS_Y = 320 * MiB;
constexpr size_t WS_MISC = 384 * MiB;
constexpr size_t WS_ST0 = WS_MISC, WS_ST1 = WS_MISC + 2 * MiB, WS_ST2 = WS_MISC + 4 * MiB;
constexpr size_t WS_MODP = WS_MISC + 6 * MiB;
constexpr size_t WS_PAR = WS_MISC + 11 * MiB;
constexpr size_t WS_WSB = WS_MISC + 12 * MiB;
constexpr size_t WS_GWT = WS_MISC + 12 * MiB + 512 * 1024;
constexpr size_t WS_SUMM = WS_MISC + 13 * MiB;
constexpr size_t WS_XB = WS_MISC + 16 * MiB;
constexpr size_t WS_END = WS_XB + 64 * MiB;
static_assert(WS_W + 2 * LAYER_W_BYTES <= WS_XN && WS_PC + (size_t)M * 512 * 2 <= WS_Y, "d_ws map");
constexpr int CW_BAR = 4096, CW_XRANK = 32768, CW_LBAR = 40960, CW_M1PUB = 53248, CW_M1DONE = 53312, CW_GVPUB = 53376;
constexpr int RING_BYTES = 131072, LDS_BYTES = 147456, LDSCTL_OFF = LDS_BYTES - 512, MISC_OFF = LDSCTL_OFF;

struct Args { const float* in[26]; float* out; unsigned char* ws; };
enum { I_X = 0, I_C, I_ADAW, I_ADAB, I_NPRE, I_NPOST, I_W13, I_W2, I_ABWIN, I_ACW, I_ACB, I_AGW, I_AGB, I_ALAM, I_BCW, I_BCB, I_BNG, I_BNB, I_ABWOUT, I_CWIN, I_CBIN, I_CNG, I_CNB, I_CWS, I_CBS, I_CWOUT };

__device__ __forceinline__ float dpp_row_shr(float v, int n) {
    const int iv = __builtin_bit_cast(int, v); int r;
    switch (n) { case 1: r = __builtin_amdgcn_update_dpp(0, iv, 0x111, 0xf, 0xf, true); break; case 2: r = __builtin_amdgcn_update_dpp(0, iv, 0x112, 0xf, 0xf, true); break;
                 case 4: r = __builtin_amdgcn_update_dpp(0, iv, 0x114, 0xf, 0xf, true); break; default: r = __builtin_amdgcn_update_dpp(0, iv, 0x118, 0xf, 0xf, true); break; }
    return __builtin_bit_cast(float, r);
}
__device__ __forceinline__ float row16_sum(float v) {
    v += dpp_row_shr(v, 1); v += dpp_row_shr(v, 2); v += dpp_row_shr(v, 4); v += dpp_row_shr(v, 8);
    return __builtin_bit_cast(float, __builtin_amdgcn_readlane(__builtin_bit_cast(int, v), 15));
}
__device__ __forceinline__ float wave_sum(float v) {
    v += dpp_row_shr(v, 1); v += dpp_row_shr(v, 2); v += dpp_row_shr(v, 4); v += dpp_row_shr(v, 8);
    v += __builtin_bit_cast(float, __builtin_amdgcn_update_dpp(0, __builtin_bit_cast(int, v), 0x142, 0xa, 0xf, false));
    v += __builtin_bit_cast(float, __builtin_amdgcn_update_dpp(0, __builtin_bit_cast(int, v), 0x143, 0xc, 0xf, false));
    return __builtin_bit_cast(float, __builtin_amdgcn_readlane(__builtin_bit_cast(int, v), 63));
}
__device__ __forceinline__ float neg_expm1(float x) {
    const float p = x * (1.0f + x * (0.5f + x * (0.16666667f + x * (0.041666668f + x * (0.0083333338f + x * 0.0013888889f)))));
    return (x > -0.25f) ? -p : 1.0f - __expf(x);
}
__device__ __forceinline__ float bf2f(unsigned h) { return __uint_as_float(h << 16); }
__device__ __forceinline__ float bflo(unsigned w) { return __uint_as_float(w << 16); }
__device__ __forceinline__ float bfhi(unsigned w) { return __uint_as_float(w & 0xffff0000u); }
__device__ __forceinline__ float fsig(float x) { return __builtin_amdgcn_rcpf(1.0f + __expf(-x)); }
__device__ __forceinline__ float gelu_t(float x) { const float u = 1.5957691216f * (x + 0.044715f * x * x * x); return x * fsig(u); }
typedef unsigned u32x2 __attribute__((ext_vector_type(2)));

struct TItem { const float* src; bf16* dst; int K, N; float sc; };
__device__ __forceinline__ TItem p0_decode(const Args& args, unsigned char* ws, int it) {
    constexpr int I13 = (D / 64) * (2 * FF / 32), I2 = (FF / 64) * (D / 32), IWIN = (D / 64) * (2048 / 32), IWOUT = (D / 64) * (D / 32);
    const float* W; bf16* WT; int K, N, mode = 0; int r = it;
    if (r < 4 * I13) { const int mi = r / I13; r -= mi * I13; W = args.in[I_W13] + (size_t)mi * D * 2 * FF; K = D; N = 2 * FF; mode = 1; WT = (bf16*)(ws + WS_W + (size_t)(mi >> 1) * LAYER_W_BYTES + LW_W13 + (size_t)(mi & 1) * W13_BYTES); }
    else { r -= 4 * I13;
        if (r < 4 * I2) { const int mi = r / I2; r -= mi * I2; W = args.in[I_W2] + (size_t)mi * FF * D; K = FF; N = D; WT = (bf16*)(ws + WS_W + (size_t)(mi >> 1) * LAYER_W_BYTES + LW_W2 + (size_t)(mi & 1) * W2_BYTES); }
        else { r -= 4 * I2;
            if (r < IWIN) { W = args.in[I_ABWIN]; K = D; N = 2048; WT = (bf16*)(ws + WS_W + LW_WIN); }
            else { r -= IWIN;
                if (r < IWIN) { W = args.in[I_CWIN]; K = D; N = 2048; WT = (bf16*)(ws + WS_W + LAYER_W_BYTES + LW_WIN); }
                else { r -= IWIN;
                    if (r < IWOUT) { W = args.in[I_ABWOUT]; K = D; N = D; WT = (bf16*)(ws + WS_W + LW_WOUT); }
                    else { r -= IWOUT; W = args.in[I_CWOUT]; K = D; N = D; WT = (bf16*)(ws + WS_W + LAYER_W_BYTES + LW_WOUT); } } } } }
    const int nblk = N / 32, kb = r / nblk, nb = r % nblk, k0 = 64 * kb, n0 = 32 * nb;
    int rowbase = n0;
    if (mode == 1) { if (n0 < FF) rowbase = 256 * (n0 >> 7) + (n0 & 127); else { const int c = n0 - FF; rowbase = 256 * (c >> 7) + 128 + (c & 127); } }
    TItem t; t.src = W + (size_t)k0 * N + n0; t.dst = WT + (size_t)rowbase * K + k0; t.K = K; t.N = N; t.sc = (mode == 1) ? (n0 < FF ? 1.4426950408889634f : 0.6931471805599453f) : 1.0f; return t;
}
__device__ __forceinline__ void p0_item_load(const TItem& t, int lane, float (&v)[32]) {
#pragma unroll
    for (int i = 0; i < 32; ++i) v[i] = t.src[(size_t)(2 * i + (lane >> 5)) * t.N + (lane & 31)];
}
__device__ __forceinline__ void p0_item_store(const TItem& t, int lane, const float (&v)[32], LAS float* scr) {
#pragma unroll
    for (int i = 0; i < 32; ++i) scr[(2 * i + (lane >> 5)) * 33 + (lane & 31)] = v[i];
    LDS_WAIT(); asm volatile("" ::: "memory");
    const int c = lane & 7;
#pragma unroll
    for (int j = 0; j < 4; ++j) { const int n = (lane >> 3) + 8 * j; const LAS float* s = scr + (8 * c) * 33 + n;
        const float sc = t.sc;
        v4u o; o.x = pk2(s[0 * 33] * sc, s[1 * 33] * sc); o.y = pk2(s[2 * 33] * sc, s[3 * 33] * sc); o.z = pk2(s[4 * 33] * sc, s[5 * 33] * sc); o.w = pk2(s[6 * 33] * sc, s[7 * 33] * sc);
        *(GAS v4u*)(t.dst + (size_t)n * t.K + 8 * c) = o; }
    LDS_WAIT(); asm volatile("" ::: "memory");
}

template <bool RES, bool NORM, int XIN, int XOUT>
__device__ __forceinline__ void trans_phase(int gw, int NGW, int lane_, const void* xin_, void* xout_, const bf16* Y, const float* st,
                                            const float* A1p, const float* A2p, const float* A3p, bf16* XN) {
    int lane = lane_; asm volatile("" : "+v"(lane));
    for (int blk = gw; blk < M / 16; blk += NGW) {
        const int rbase = blk * 16, b = rbase / SEQ;
        f32x4 A1[4], A2[4], A3[4];
#pragma unroll
        for (int j = 0; j < 4; ++j) {
            if (RES) A1[j] = *(const f32x4*)(A1p + b * 3072 + 4 * lane + 256 * j);
            if (NORM) { A2[j] = *(const f32x4*)(A2p + b * 3072 + 4 * lane + 256 * j); A3[j] = *(const f32x4*)(A3p + b * 3072 + 4 * lane + 256 * j); }
        }
#pragma unroll 1
        for (int r4 = 0; r4 < 16; r4 += 4) {
            f32x4 xv[4][4]; u32x2 xb[4][4]; u32x2 yv[4][4]; float sp[4];
#pragma unroll
            for (int r = 0; r < 4; ++r) { const size_t row = (size_t)(rbase + r4 + r);
#pragma unroll
                for (int j = 0; j < 4; ++j) { if (XIN == 0) xv[r][j] = *(const f32x4*)((const float*)xin_ + row * D + 4 * lane + 256 * j); else xb[r][j] = *(const u32x2*)((const bf16*)xin_ + row * D + 4 * lane + 256 * j); }
                if (RES) {
#pragma unroll
                    for (int j = 0; j < 4; ++j) yv[r][j] = *(const u32x2*)(Y + row * D + 4 * lane + 256 * j);
                    sp[r] = st[row * 16 + (lane & 15)]; } }
#pragma unroll
            for (int r = 0; r < 4; ++r) { const size_t row = (size_t)(rbase + r4 + r);
                if (XIN == 1) {
#pragma unroll
                    for (int j = 0; j < 4; ++j) xv[r][j] = (f32x4){bflo(xb[r][j].x), bfhi(xb[r][j].x), bflo(xb[r][j].y), bfhi(xb[r][j].y)}; }
                if (RES) {
                    const float ss = row16_sum(sp[r]);
                    const float rstd = rsqrtf(ss * (1.0f / D) + EPS);
#pragma unroll
                    for (int j = 0; j < 4; ++j) { const f32x4 y = (f32x4){bflo(yv[r][j].x), bfhi(yv[r][j].x), bflo(yv[r][j].y), bfhi(yv[r][j].y)};
                        xv[r][j] = xv[r][j] + A1[j] * y * rstd; }
                }
                if (XOUT == 2) {
#pragma unroll
                    for (int j = 0; j < 4; ++j) *(f32x4*)((float*)xout_ + row * D + 4 * lane + 256 * j) = xv[r][j]; }
                if (XOUT == 1) {
#pragma unroll
                    for (int j = 0; j < 4; ++j) { u32x2 w; w.x = pg8::cvt_pk_bf16(xv[r][j].x, xv[r][j].y); w.y = pg8::cvt_pk_bf16(xv[r][j].z, xv[r][j].w);
                        *(u32x2*)((bf16*)xout_ + row * D + 4 * lane + 256 * j) = w; } }
                if (NORM) {
                    float q = 0.f;
#pragma unroll
                    for (int j = 0; j < 4; ++j) q += (xv[r][j].x * xv[r][j].x + xv[r][j].y * xv[r][j].y) + (xv[r][j].z * xv[r][j].z + xv[r][j].w * xv[r][j].w);
                    q = wave_sum(q);
                    const float r2 = rsqrtf(q * (1.0f / D) + EPS);
#pragma unroll
                    for (int j = 0; j < 4; ++j) { const f32x4 h = xv[r][j] * r2 * A2[j] + A3[j];
                        u32x2 w; w.x = pg8::cvt_pk_bf16(h.x, h.y); w.y = pg8::cvt_pk_bf16(h.z, h.w);
                        *(u32x2*)(XN + row * D + 4 * lane + 256 * j) = w; }
                }
            }
        }
    }
}

template <int PASS>
__device__ __forceinline__ void m1_partA(const Args& a, unsigned char* ws, LAS unsigned char* lds, int ci, int w, int lane_) {
    int lane = lane_; asm volatile("" : "+v"(lane));
    const bf16* Z = (const bf16*)(ws + WS_ACT); float* SUMM = (float*)(ws + WS_SUMM); bf16* YCAT = (bf16*)(ws + WS_XN);
    const int ch = w * 64 + lane, row0 = ci * 128; const bool first = (ci % (SEQ / 128)) == 0;
    LAS bf16* xcl = (LAS bf16*)(lds + w * 10752);
    LAS float* gl = (LAS float*)(lds + w * 10752 + 2304);
    const int fr = lane & 15, fq = lane >> 4;
    const bf16* GWT = (const bf16*)(ws + WS_GWT);
    bf16x8 gB[8][2];
#pragma unroll
    for (int et = 0; et < 8; ++et)
#pragma unroll
        for (int ks = 0; ks < 2; ++ks) gB[et][ks] = *(const bf16x8*)(GWT + ((size_t)w * 128 + et * 16 + fr) * 64 + ks * 32 + 8 * fq);
    const float* cwp = a.in[I_ACW];
    const float cw0 = cwp[ch], cw1 = cwp[512 + ch], cw2 = cwp[1024 + ch], cw3 = cwp[1536 + ch], cb = a.in[I_ACB][ch];
    const float lam = a.in[I_ALAM][ch];
    const float c8 = -8.0f * log1pf(expf(-lam));
    const bool small_all = __builtin_amdgcn_ballot_w64(c8 > -0.25f) == ~0ull;
    const float gbr = a.in[I_AGB][w * 128 + lane], gbi = a.in[I_AGB][w * 128 + 64 + lane];
    const bf16* zx = Z + 512 + ch; const bf16* zg = Z + ch;
    float xm3 = 0.f, xm2 = 0.f, xm1 = 0.f;
    if (!first) { xm3 = bf2f(zx[(size_t)(row0 - 3) * 2048]); xm2 = bf2f(zx[(size_t)(row0 - 2) * 2048]); xm1 = bf2f(zx[(size_t)(row0 - 1) * 2048]); }
    float hl = 0.f, P = 1.f;
    if (PASS == 1) { const int c0 = (ci / (SEQ / 128)) * (SEQ / 128);
#pragma unroll 32
        for (int c = c0; c < ci; ++c) { const pg8::f32x2 sm = *(const pg8::f32x2*)(SUMM + ((size_t)c * 512 + ch) * 2); hl = sm.x * hl + sm.y; } }
    unsigned short nx[16], ng[16];
#pragma unroll
    for (int i = 0; i < 16; ++i) { nx[i] = zx[(size_t)(row0 + i) * 2048]; if (PASS == 1) ng[i] = zg[(size_t)(row0 + i) * 2048]; }
#pragma unroll 1
    for (int sc = 0; sc < 8; ++sc) {
        float xc[16]; float ag[16];
#pragma unroll
        for (int i = 0; i < 16; ++i) { const float x = bf2f(nx[i]); xc[i] = cb + cw0 * xm3 + cw1 * xm2 + cw2 * xm1 + cw3 * x; xm3 = xm2; xm2 = xm1; xm1 = x;
            if (PASS == 1) ag[i] = bf2f(ng[i]);
            xcl[i * 72 + lane] = (bf16)f2bf(xc[i]); }
        if (sc < 7) {
#pragma unroll
            for (int i = 0; i < 16; ++i) { nx[i] = zx[(size_t)(row0 + 16 * (sc + 1) + i) * 2048]; if (PASS == 1) ng[i] = zg[(size_t)(row0 + 16 * (sc + 1) + i) * 2048]; } }
        LDS_WAIT(); asm volatile("" ::: "memory");
        f32x4 acc[8];
#pragma unroll
        for (int et = 0; et < 8; ++et) acc[et] = (f32x4){0.f, 0.f, 0.f, 0.f};
#pragma unroll
        for (int ks = 0; ks < 2; ++ks) { const bf16x8 af = *(const LAS bf16x8*)(xcl + fr * 72 + ks * 32 + 8 * fq);
#pragma unroll
            for (int et = 0; et < 8; ++et) acc[et] = __builtin_amdgcn_mfma_f32_16x16x32_bf16(af, gB[et][ks], acc[et], 0, 0, 0); }
#pragma unroll
        for (int et = 0; et < 8; ++et)
#pragma unroll
            for (int r = 0; r < 4; ++r) gl[(4 * fq + r) * 132 + et * 16 + fr] = acc[et][r];
        LDS_WAIT(); asm volatile("" ::: "memory");
#pragma unroll
        for (int i = 0; i < 16; i += 2) {
            typedef pg8::f32x2 v2;
            const v2 gr = (v2){gl[i * 132 + lane], gl[(i + 1) * 132 + lane]} + gbr, gi = (v2){gl[i * 132 + 64 + lane], gl[(i + 1) * 132 + 64 + lane]} + gbi;
            const v2 tr = gr * (-1.4426950408889634f), ti = gi * (-1.4426950408889634f);
            v2 dr, di; dr.x = __builtin_amdgcn_exp2f(tr.x); dr.y = __builtin_amdgcn_exp2f(tr.y); di.x = __builtin_amdgcn_exp2f(ti.x); di.y = __builtin_amdgcn_exp2f(ti.y);
            dr = dr + 1.0f; di = di + 1.0f;
            v2 r, ig; r.x = __builtin_amdgcn_rcpf(dr.x); r.y = __builtin_amdgcn_rcpf(dr.y); ig.x = __builtin_amdgcn_rcpf(di.x); ig.y = __builtin_amdgcn_rcpf(di.y);
            const v2 la = r * c8;
            v2 em;
            if (small_all) { v2 q = la * 0.0013888889f + 0.0083333338f; q = q * la + 0.041666668f; q = q * la + 0.16666667f; q = q * la + 0.5f; q = q * la + 1.0f; em = q * la; }
            else { em.x = __expf(la.x) - 1.0f; em.y = __expf(la.y) - 1.0f; }
            const v2 av = em + 1.0f, m2 = -em * (em + 2.0f);
            v2 mult; mult.x = __builtin_amdgcn_sqrtf(m2.x); mult.y = __builtin_amdgcn_sqrtf(m2.y);
            const v2 uu = mult * ig * (v2){xc[i], xc[i + 1]};
            const float h0 = av.x * hl + uu.x, h1 = av.y * h0 + uu.y; hl = h1;
            if (PASS == 0) P *= av.x * av.y;
            else { const v2 g = (v2){ag[i], ag[i + 1]};
                const v2 tg = (g * g * 0.044715f + 1.0f) * g * (-1.5957691216f * 1.4426950408889634f);
                v2 dg; dg.x = __builtin_amdgcn_exp2f(tg.x); dg.y = __builtin_amdgcn_exp2f(tg.y); dg = dg + 1.0f;
                v2 rg; rg.x = __builtin_amdgcn_rcpf(dg.x); rg.y = __builtin_amdgcn_rcpf(dg.y);
                const v2 y = (v2){h0, h1} * g * rg;
                YCAT[(size_t)(row0 + 16 * sc + i) * 1024 + ch] = (bf16)f2bf(y.x); YCAT[(size_t)(row0 + 16 * sc + i + 1) * 1024 + ch] = (bf16)f2bf(y.y); }
        }
        LDS_WAIT(); asm volatile("" ::: "memory");
    }
    if (PASS == 0)
        __hip_atomic_store((unsigned long long*)(SUMM + ((size_t)ci * 512 + ch) * 2), ((unsigned long long)__float_as_uint(hl) << 32) | (unsigned long long)__float_as_uint(P), __ATOMIC_RELAXED, __HIP_MEMORY_SCOPE_AGENT);
}

__device__ __forceinline__ void m1_partB(const Args& a, unsigned char* ws, int ci, int w, int lane_) {
    int lane = lane_; asm volatile("" : "+v"(lane));
    const bf16* Z = (const bf16*)(ws + WS_ACT); bf16* YCAT = (bf16*)(ws + WS_XN);
    const int ch = w * 64 + lane, row0 = ci * 128; const bool first = (ci % (SEQ / 128)) == 0;
    {
        float bw[31];
#pragma unroll
        for (int k = 0; k < 31; ++k) bw[k] = a.in[I_BCW][k * 512 + ch];
        const float bb = a.in[I_BCB][ch], ng = a.in[I_BNG][ch], nb = a.in[I_BNB][ch];
        const bf16* zv = Z + 1024 + ch; const bf16* zg = Z + 1536 + ch;
        float win[32];
        win[0] = 0.f; win[1] = 0.f;
#pragma unroll
        for (int j = 2; j < 32; ++j) { float v = 0.f; if (!first) { const size_t row = (size_t)(row0 - 32 + j); v = bf2f(zv[row * 2048]) * fsig(bf2f(zg[row * 2048])); } win[j] = v; }
#pragma unroll 1
        for (int base = 0; base < 128; base += 32) {
            unsigned rvg[32];
#pragma unroll
            for (int j = 0; j < 32; ++j) { const size_t row = (size_t)(row0 + base + j); rvg[j] = (unsigned)zv[row * 2048] | ((unsigned)zg[row * 2048] << 16); }
#pragma unroll
            for (int j4 = 0; j4 < 32; j4 += 4) {
                float ac[4], dl[4], vr[4];
#pragma unroll
                for (int q = 0; q < 4; ++q) { const int j = j4 + q; win[j] = bflo(rvg[j]) * fsig(bfhi(rvg[j]));
                    float acc = bb;
#pragma unroll
                    for (int k = 0; k < 31; ++k) acc += bw[k] * win[(j + 2 + k) & 31];
                    ac[q] = acc; }
#pragma unroll
                for (int q = 0; q < 4; ++q) dl[q] = ac[q] - wave_sum(ac[q]) * (1.0f / 64.0f);
#pragma unroll
                for (int q = 0; q < 4; ++q) vr[q] = wave_sum(dl[q] * dl[q]) * (1.0f / 64.0f);
#pragma unroll
                for (int q = 0; q < 4; ++q) { const float y = dl[q] * rsqrtf(vr[q] + EPS) * ng + nb;
                    YCAT[(size_t)(row0 + base + j4 + q) * 1024 + 512 + ch] = (bf16)f2bf(y * fsig(y)); }
            }
        }
    }
}

__device__ __forceinline__ void sg_chunk(const Args& a, unsigned char* ws, LAS unsigned char* lds, int ci, int w, int lane_, int tid_) {
    int lane = lane_, tid = tid_; asm volatile("" : "+v"(lane), "+v"(tid));
    const bf16* Z = (const bf16*)(ws + WS_ACT); bf16* UG = (bf16*)(ws + WS_XN); const bf16* WSB = (const bf16*)(ws + WS_WSB);
    const float* S1 = (const float*)(ws + WS_ST1); const float* S2 = (const float*)(ws + WS_ST2);
    LAS float* sm = (LAS float*)lds;
    LAS bf16* vT = (LAS bf16*)(lds + 1024 + w * 17408);
    const int row0 = ci * 128;
    if (tid < 128) { const size_t row = (size_t)(row0 + tid); float s1 = 0.f, s2 = 0.f;
#pragma unroll
        for (int i = 0; i < 4; ++i) { const f32x4 p = *(const f32x4*)(S1 + row * 16 + 4 * i), q = *(const f32x4*)(S2 + row * 16 + 4 * i); s1 += (p.x + p.y) + (p.z + p.w); s2 += (q.x + q.y) + (q.z + q.w); }
        const float mean = s1 * (1.0f / 1024.0f), var = s2 * (1.0f / 1024.0f) - mean * mean;
        sm[2 * tid] = mean; sm[2 * tid + 1] = rsqrtf(var + EPS); }
    __syncthreads();
    const int fr = lane & 15, fq = lane >> 4;
    bf16x8 yfr[8][4];
#pragma unroll
    for (int tt = 0; tt < 8; ++tt)
#pragma unroll
        for (int ks = 0; ks < 4; ++ks) if (ks < tt / 2 + 1) yfr[tt][ks] = *(const bf16x8*)(WSB + ((size_t)w * 128 + tt * 16 + fr) * 128 + ks * 32 + 8 * fq);
#pragma unroll 1
    for (int hh = 0; hh < 2; ++hh) {
        const int cbase = w * 128 + hh * 64;
        { const int csub = (lane & 7) * 8, sl = lane >> 3;
            float g8[8], b8[8];
#pragma unroll
            for (int e = 0; e < 8; ++e) { g8[e] = a.in[I_CNG][cbase + csub + e]; b8[e] = a.in[I_CNB][cbase + csub + e]; }
#pragma unroll 1
            for (int i0 = 0; i0 < 16; i0 += 8) {
                v4u raw[8];
#pragma unroll
                for (int i = 0; i < 8; ++i) raw[i] = *(const v4u*)(Z + (size_t)(row0 + sl + 8 * (i0 + i)) * 2048 + 1024 + cbase + csub);
#pragma unroll
                for (int i = 0; i < 8; ++i) { const int s = sl + 8 * (i0 + i);
                    const float mean = sm[2 * s], rstd = sm[2 * s + 1];
                    const unsigned rw[4] = {raw[i].x, raw[i].y, raw[i].z, raw[i].w};
#pragma unroll
                    for (int e = 0; e < 8; ++e) { const float v = (e & 1) ? bfhi(rw[e >> 1]) : bflo(rw[e >> 1]);
                        vT[(csub + e) * 136 + (s ^ csub)] = (bf16)f2bf((v - mean) * rstd * g8[e] + b8[e]); } }
            }
        }
        LDS_WAIT(); asm volatile("" ::: "memory");
#pragma unroll
        for (int tt = 0; tt < 8; ++tt) {
            const int t = tt * 16 + fr; const size_t row = (size_t)(row0 + t); const float bs = a.in[I_CBS][w * 128 + t];
            u32x2 uu[4];
#pragma unroll
            for (int ct = 0; ct < 4; ++ct) uu[ct] = *(const u32x2*)(Z + row * 2048 + cbase + ct * 16 + 4 * fq);
            f32x4 acc[4];
#pragma unroll
            for (int ct = 0; ct < 4; ++ct) acc[ct] = (f32x4){0.f, 0.f, 0.f, 0.f};
#pragma unroll
            for (int ks = 0; ks < tt / 2 + 1; ++ks) {
#pragma unroll
                for (int ct = 0; ct < 4; ++ct) { const bf16x8 xf = *(const LAS bf16x8*)(vT + (ct * 16 + fr) * 136 + ((ks * 32 + 8 * fq) ^ (((ct * 16 + fr) >> 3) << 3)));
                    acc[ct] = __builtin_amdgcn_mfma_f32_16x16x32_bf16(xf, yfr[tt][ks], acc[ct], 0, 0, 0); }
            }
#pragma unroll
            for (int ct = 0; ct < 4; ++ct) { const int cc = cbase + ct * 16 + 4 * fq;
                u32x2 o; o.x = pg8::cvt_pk_bf16(bflo(uu[ct].x) * (acc[ct][0] + bs), bfhi(uu[ct].x) * (acc[ct][1] + bs)); o.y = pg8::cvt_pk_bf16(bflo(uu[ct].y) * (acc[ct][2] + bs), bfhi(uu[ct].y) * (acc[ct][3] + bs));
                *(u32x2*)(UG + row * 1024 + cc) = o; }
        }
        LDS_WAIT(); asm volatile("" ::: "memory");
    }
    __syncthreads();
}

struct FastOrder : pg8::StaticOrder {
    __device__ __forceinline__ bool next(int i, pg8::Unit& u) const {
        const long L = (long)i * G + c; if (L >= nwg) return false;
        if ((nwg & 7) | (nM & 7)) return pg8::StaticOrder::next(i, u);
        const unsigned wl = (unsigned)L, wgid = (wl & 7u) * (unsigned)(nwg >> 3) + (wl >> 3), t = wgid >> 3, gid = t / (unsigned)nN;
        u.pm = (int)(gid * 8u + (wgid & 7u)); u.pn = (int)(t - gid * (unsigned)nN); return true; }
};

__global__ void __launch_bounds__(NTHR, 2) mega_fwd(Args args) {
    extern __shared__ __attribute__((aligned(16))) unsigned char lds_raw[];
    LAS unsigned char* lds = (LAS unsigned char*)lds_raw;
    volatile LAS unsigned* MISC = (volatile LAS unsigned*)(lds + MISC_OFF);
    const int tid = threadIdx.x, lane = tid & 63, wave = __builtin_amdgcn_readfirstlane(tid >> 6);
    const int G = gridDim.x, bx = blockIdx.x;
    const int gw = bx * NWAVES + wave, NGW = G * NWAVES;
    unsigned char* ws = args.ws;
    gu32* ctl = (gu32*)(ws + WS_CTL);
    for (int u = tid; u < (LDS_BYTES - LDSCTL_OFF) / 4; u += NTHR) ((LAS unsigned*)(lds + LDSCTL_OFF))[u] = 0u;
    __syncthreads();
    XcdBarrier bar = xcd_barrier_post((unsigned*)(ctl + CW_BAR), MISC + 8);
#define GRID_BAR() xcd_barrier(bar)
    if (tid == 0) MISC[16] = __hip_atomic_fetch_add((unsigned*)(ctl + CW_XRANK) + 64 * (bar.x & 7u), 1u, __ATOMIC_RELAXED, __HIP_MEMORY_SCOPE_AGENT);
    int cv = bx; bool loc_ok = false;
    unsigned* lb_cnt = (unsigned*)(ctl + CW_LBAR); unsigned* lb_gen = lb_cnt + 64;
#define LOC_BAR() do { if (loc_ok) { \
        asm volatile("s_waitcnt vmcnt(0)" ::: "memory"); __syncthreads(); \
        if (tid == 0) { __builtin_amdgcn_s_waitcnt(0); const unsigned old_ = xb_add(lb_cnt, 1u), g_ = old_ / 4u; \
            if (old_ + 1u == (g_ + 1u) * 4u) xb_add(lb_gen, 1u); \
            else { unsigned sp_ = 0u; while (xb_ld(lb_gen) == g_) { __builtin_amdgcn_s_sleep(1); if (++sp_ > (1u << 24)) break; } } \
            __builtin_amdgcn_fence(__ATOMIC_ACQUIRE, "agent"); asm volatile("s_waitcnt vmcnt(0)" ::: "memory"); } \
        __syncthreads(); } else xcd_barrier(bar); } while (0)

    float* PAR = (float*)(ws + WS_PAR);
    bf16* XB = (bf16*)(ws + WS_XB);
    bf16* XN = (bf16*)(ws + WS_XN); bf16* ACT = (bf16*)(ws + WS_ACT); bf16* YB = (bf16*)(ws + WS_Y);
    float* ST0 = (float*)(ws + WS_ST0); float* ST1 = (float*)(ws + WS_ST1); float* ST2 = (float*)(ws + WS_ST2);
#define PARP(l, s, q) (PAR + ((size_t)((l) * 3 + (s)) * 2) * 3072 + (q) * 1024)

    {
        { float* MODP = (float*)(ws + WS_MODP); const float* cp = args.in[I_C];
            for (int it = gw; it < 2 * 36 * 32; it += NGW) { const int l = it / 1152, rem = it % 1152, jb = rem / 32, kw = rem % 32;
                const float* wp = args.in[I_ADAW] + ((size_t)l * 1024 + kw * 32) * 9216 + jb * 256 + 4 * lane;
                f32x4 a0 = (f32x4){0.f, 0.f, 0.f, 0.f}, a1 = a0;
#pragma unroll 8
                for (int k = 0; k < 32; ++k) { const f32x4 wv = *(const f32x4*)(wp + (size_t)k * 9216);
                    const float c0 = cp[kw * 32 + k], c1 = cp[1024 + kw * 32 + k];
                    const float s0 = c0 / (1.0f + expf(-c0)), s1 = c1 / (1.0f + expf(-c1));
                    a0 = a0 + wv * s0; a1 = a1 + wv * s1; }
                unsigned long long* q0 = (unsigned long long*)(MODP + ((size_t)(kw * 2 + l) * 2 + 0) * 9216 + jb * 256 + 4 * lane);
                unsigned long long* q1 = (unsigned long long*)(MODP + ((size_t)(kw * 2 + l) * 2 + 1) * 9216 + jb * 256 + 4 * lane);
                __hip_atomic_store(q0, ((unsigned long long)__float_as_uint(a0.y) << 32) | __float_as_uint(a0.x), __ATOMIC_RELAXED, __HIP_MEMORY_SCOPE_AGENT);
                __hip_atomic_store(q0 + 1, ((unsigned long long)__float_as_uint(a0.w) << 32) | __float_as_uint(a0.z), __ATOMIC_RELAXED, __HIP_MEMORY_SCOPE_AGENT);
                __hip_atomic_store(q1, ((unsigned long long)__float_as_uint(a1.y) << 32) | __float_as_uint(a1.x), __ATOMIC_RELAXED, __HIP_MEMORY_SCOPE_AGENT);
                __hip_atomic_store(q1 + 1, ((unsigned long long)__float_as_uint(a1.w) << 32) | __float_as_uint(a1.z), __ATOMIC_RELAXED, __HIP_MEMORY_SCOPE_AGENT); } }
    }
    asm volatile("s_waitcnt vmcnt(0)" ::: "memory"); __syncthreads();
    if (tid == 0) __hip_atomic_fetch_add((unsigned*)(ctl + CW_GVPUB), 1u, __ATOMIC_RELAXED, __HIP_MEMORY_SCOPE_AGENT);
    {
        LAS float* scr = (LAS float*)(lds + wave * 16384);
        constexpr int NITEMS = 4 * (D / 64) * (2 * FF / 32) + 4 * (FF / 64) * (D / 32) + 2 * (D / 64) * (2048 / 32) + 2 * (D / 64) * (D / 32);
        if (gw < NITEMS) {
            TItem cur = p0_decode(args, ws, gw); float v[32]; p0_item_load(cur, lane, v);
#pragma unroll 1
            for (int it = gw; it < NITEMS; it += NGW) {
                const int nit = it + NGW; const bool more = nit < NITEMS;
                TItem nxt = cur; float vn[32];
                if (more) { nxt = p0_decode(args, ws, nit); p0_item_load(nxt, lane, vn); }
                p0_item_store(cur, lane, v, scr);
                if (more) {
#pragma unroll
                    for (int i = 0; i < 32; ++i) v[i] = vn[i];
                    cur = nxt; }
            }
        }
        { bf16* WSB = (bf16*)(ws + WS_WSB); const float* wsp = args.in[I_CWS];
            for (int e = bx * NTHR + tid; e < 8 * 128 * 128; e += G * NTHR) { const int s = e & 127, t = (e >> 7) & 127; WSB[e] = (bf16)f2bf(s <= t ? wsp[e] : 0.f); } }
        { bf16* GWT = (bf16*)(ws + WS_GWT); const float* gp = args.in[I_AGW];
            for (int e = bx * NTHR + tid; e < 8 * 128 * 64; e += G * NTHR) { const int d = e & 63, ee = (e >> 6) & 127, h = e >> 13; GWT[e] = (bf16)f2bf(gp[((size_t)h * 64 + d) * 128 + ee]); } }
    }
    if (tid == 0) { unsigned sp_ = 0u; while (__hip_atomic_load((unsigned*)(ctl + CW_GVPUB), __ATOMIC_RELAXED, __HIP_MEMORY_SCOPE_AGENT) < (unsigned)G) { __builtin_amdgcn_s_sleep(2); if (++sp_ > (1u << 24)) break; }
        __builtin_amdgcn_fence(__ATOMIC_ACQUIRE, "agent"); asm volatile("s_waitcnt vmcnt(0)" ::: "memory"); }
    __syncthreads();
    { bool even = (G == 256);
#pragma unroll
        for (int j = 0; j < 8; ++j) even = even && (__hip_atomic_load((unsigned*)(ctl + CW_XRANK) + 64 * j, __ATOMIC_RELAXED, __HIP_MEMORY_SCOPE_AGENT) == 32u);
        loc_ok = even; if (even) cv = (int)(bar.x & 7u) + 8 * (int)MISC[16];
        cv = __builtin_amdgcn_readfirstlane(cv); }
    const int gm_ = (cv >> 3) & 7, gq_ = cv >> 6;
    const int hp = (G == 256) ? 2 * (16 * (cv & 7) + 8 * (gq_ >> 1) + gm_) + (gq_ & 1) : bx;
    lb_cnt = (unsigned*)(ctl + CW_LBAR) + 128 * (8 * (cv & 7) + gm_); lb_gen = lb_cnt + 64;
    const int gwm = hp * NWAVES + wave;
    {
        const float* MODP = (const float*)(ws + WS_MODP);
        const int per = (2 * 3 * 2 * 1024 + G - 1) / G;
        for (int t = bx * per + tid; tid < per && t < 2 * 3 * 2 * 1024 && t < (bx + 1) * per; t += NTHR) {
            const int c = t & 1023, b = (t >> 10) & 1, ls = t >> 11, l = ls / 3, s = ls % 3;
            float v[3];
#pragma unroll
            for (int q = 0; q < 3; ++q) { float pv[32];
#pragma unroll
                for (int kw = 0; kw < 32; ++kw) pv[kw] = MODP[((size_t)(kw * 2 + l) * 2 + b) * 9216 + s * 3072 + q * 1024 + c];
                float acc = args.in[I_ADAB][l * 9216 + s * 3072 + q * 1024 + c];
#pragma unroll
                for (int kw = 0; kw < 32; ++kw) acc += pv[kw];
                v[q] = acc; }
            const float resw = (s == 1) ? 1.0f : 0.5f;
            float* p = PAR + ((size_t)(l * 3 + s) * 2 + b) * 3072 + c;
            p[0] = resw * (1.0f + v[2]) * args.in[I_NPOST][(l * 3 + s) * 1024 + c];
            p[1024] = args.in[I_NPRE][(l * 3 + s) * 1024 + c] * (1.0f + v[1]);
            p[2048] = v[0];
        }
    }
    GRID_BAR();
    trans_phase<false, true, 0, 1>(gwm, NGW, lane, args.in[I_X], XB, nullptr, nullptr, nullptr, PARP(0, 0, 1), PARP(0, 0, 2), XN);
    LOC_BAR();

#pragma unroll 1
    for (int l = 0; l < 2; ++l) {
        unsigned char* wl = ws + WS_W + (size_t)l * LAYER_W_BYTES;
#pragma unroll 1
        for (int s = 0; s < 3; ++s) {
            if (s != 1) {
                const int fi = s >> 1;
                if (l == 0 && s == 2) {
                    if (tid == 0) { unsigned sp_ = 0u; while (__hip_atomic_load((unsigned*)(ctl + CW_M1DONE), __ATOMIC_RELAXED, __HIP_MEMORY_SCOPE_AGENT) < (unsigned)G) { __builtin_amdgcn_s_sleep(2); if (++sp_ > (1u << 24)) break; } }
                    __syncthreads(); }
                { pg8::Gemm g{XN, (const bf16*)(wl + LW_W13 + (size_t)fi * W13_BYTES), M, 2 * FF, D}; FastOrder S; S.init(M, 2 * FF, G, cv);
                    pg8::EpiX<1> E{ACT, FF, nullptr, nullptr, nullptr};
                    pg8::gemm_phase<pg8::EpiX<1>, FastOrder, true, true>(lds, g, S, E); }
                LOC_BAR();
                { pg8::Gemm g{ACT, (const bf16*)(wl + LW_W2 + (size_t)fi * W2_BYTES), M, D, FF}; FastOrder S; S.init(M, D, G, cv);
                    pg8::EpiX<2> E{YB, D, nullptr, ST0, nullptr};
                    pg8::gemm_phase<pg8::EpiX<2>, FastOrder, true, true>(lds, g, S, E); }
                LOC_BAR();
            } else if (l == 0) {
                { pg8::Gemm g{XN, (const bf16*)(wl + LW_WIN), M, 2048, D}; FastOrder S; S.init(M, 2048, G, cv);
                    pg8::EpiX<0> E{ACT, 2048, nullptr, nullptr, nullptr};
                    pg8::gemm_phase<pg8::EpiX<0>, FastOrder, true, true>(lds, g, S, E); }
                GRID_BAR();
                for (int ci = hp; ci < NCHUNK; ci += G) m1_partA<0>(args, ws, lds, ci, wave, lane);
                asm volatile("s_waitcnt vmcnt(0)" ::: "memory"); __syncthreads();
                if (tid == 0) __hip_atomic_fetch_add((unsigned*)(ctl + CW_M1PUB), 1u, __ATOMIC_RELAXED, __HIP_MEMORY_SCOPE_AGENT);
                for (int ci = hp; ci < NCHUNK; ci += G) m1_partB(args, ws, ci, wave, lane);
                if (tid == 0) { unsigned sp_ = 0u; while (__hip_atomic_load((unsigned*)(ctl + CW_M1PUB), __ATOMIC_RELAXED, __HIP_MEMORY_SCOPE_AGENT) < (unsigned)G) { __builtin_amdgcn_s_sleep(2); if (++sp_ > (1u << 24)) break; }
                    __builtin_amdgcn_fence(__ATOMIC_ACQUIRE, "agent"); asm volatile("s_waitcnt vmcnt(0)" ::: "memory"); }
                __syncthreads();
                for (int ci = hp; ci < NCHUNK; ci += G) m1_partA<1>(args, ws, lds, ci, wave, lane);
                asm volatile("s_waitcnt vmcnt(0)" ::: "memory"); __syncthreads();
                if (tid == 0) __hip_atomic_fetch_add((unsigned*)(ctl + CW_M1DONE), 1u, __ATOMIC_RELAXED, __HIP_MEMORY_SCOPE_AGENT);
                LOC_BAR();
                { pg8::Gemm g{XN, (const bf16*)(wl + LW_WOUT), M, D, D}; FastOrder S; S.init(M, D, G, cv);
                    pg8::EpiX<2> E{YB, D, nullptr, ST0, nullptr};
                    pg8::gemm_phase<pg8::EpiX<2>, FastOrder, true, true>(lds, g, S, E); }
                LOC_BAR();
            } else {
                { pg8::Gemm g{XN, (const bf16*)(wl + LW_WIN), M, 2048, D}; FastOrder S; S.init(M, 2048, G, cv);
                    pg8::EpiX<3> E{ACT, 2048, args.in[I_CBIN], ST1, ST2};
                    pg8::gemm_phase<pg8::EpiX<3>, FastOrder, true, true>(lds, g, S, E); }
                LOC_BAR();
                for (int ci = hp; ci < NCHUNK; ci += G) sg_chunk(args, ws, lds, ci, wave, lane, tid);
                LOC_BAR();
                { pg8::Gemm g{XN, (const bf16*)(wl + LW_WOUT), M, D, D}; FastOrder S; S.init(M, D, G, cv);
                    pg8::EpiX<2> E{YB, D, nullptr, ST0, nullptr};
                    pg8::gemm_phase<pg8::EpiX<2>, FastOrder, true, true>(lds, g, S, E); }
                LOC_BAR();
            }
            if (l == 1 && s == 2) trans_phase<true, false, 1, 2>(gwm, NGW, lane, XB, args.out, YB, ST0, PARP(l, s, 0), nullptr, nullptr, nullptr);
            else { const int nl = (s == 2) ? l + 1 : l, ns = (s == 2) ? 0 : s + 1;
                trans_phase<true, true, 1, 1>(gwm, NGW, lane, XB, XB, YB, ST0, PARP(l, s, 0), PARP(nl, ns, 1), PARP(nl, ns, 2), XN);
                LOC_BAR(); }
        }
    }
    cg::this_grid().sync();
}

extern "C" void kernel_launch(void* const* d_in, const int* in_sizes, int n_in, void* d_out, int out_size, void* d_ws, size_t ws_size, hipStream_t stream) {
    static int grid = 0;
    if (grid == 0) {
        if (n_in != 26 || in_sizes[0] != M * D || out_size != M * D || ws_size < WS_END) { fprintf(stderr, "kernel_launch: unexpected shapes (n_in %d, in0 %d, out %d, ws %zu)\n", n_in, n_in > 0 ? in_sizes[0] : -1, out_size, ws_size); grid = -1; return; }
        int dev = 0, cus = 0, per_cu = 0;
        if (hipGetDevice(&dev) != hipSuccess || hipDeviceGetAttribute(&cus, hipDeviceAttributeMultiprocessorCount, dev) != hipSuccess) { grid = -1; return; }
        if (hipFuncSetAttribute((const void*)mega_fwd, hipFuncAttributeMaxDynamicSharedMemorySize, LDS_BYTES) != hipSuccess) { fprintf(stderr, "kernel_launch: hipFuncSetAttribute failed\n"); grid = -1; return; }
        if (hipOccupancyMaxActiveBlocksPerMultiprocessor(&per_cu, (const void*)mega_fwd, NTHR, LDS_BYTES) != hipSuccess || per_cu < 1) { fprintf(stderr, "kernel_launch: occupancy query says %d\n", per_cu); per_cu = 1; }
        (void)hipGetLastError();
        grid = cus;
    }
    if (grid < 0) return;
    (void)hipMemsetAsync((char*)d_ws + WS_CTL, 0, CTL_ZERO_BYTES, stream);
    Args a{};
    for (int i = 0; i < 26; ++i) a.in[i] = (const float*)d_in[i];
    a.out = (float*)d_out; a.ws = (unsigned char*)d_ws;
    void* kargs[] = {&a};
    const hipError_t le = hipLaunchCooperativeKernel((const void*)mega_fwd, dim3(grid), dim3(NTHR), kargs, LDS_BYTES, stream);
    if (le != hipSuccess) fprintf(stderr, "kernel_launch: cooperative launch failed: %s (grid %d)\n", hipGetErrorName(le), grid);
}
```

```cpp
#include <hip/hip_runtime.h>
#include <hip/hip_cooperative_groups.h>
#include <cstdio>
#include <cstdint>
namespace cg = cooperative_groups;
namespace pg8 {
#define PG8_LAS __attribute__((address_space(3)))
typedef unsigned short bf16_t;
typedef short bf16x8 __attribute__((ext_vector_type(8)));
typedef float f32x4 __attribute__((ext_vector_type(4)));
typedef unsigned u32x4 __attribute__((ext_vector_type(4)));
constexpr int BM = 256, BK = 64, HALF = 128, HTB = HALF * BK * 2  , STAGE_BYTES = 8 * HTB, NXCD = 8, WGM = 8;

__host__ __device__ __forceinline__ int lds_byte(int r, int c) { const int st = (r >> 4) * 2 + (c >> 5), rr = r & 15, cc = c & 31, ob = rr * 64 + cc * 2; return st * 1024 + (ob ^ (((ob >> 9) & 1) << 5)); }
__host__ __device__ __forceinline__ void stage_rc(int b, int& R, int& C) { const int st = b / 1024, sb = b % 1024, swz = sb ^ (((sb >> 9) & 1) << 5); R = (st >> 1) * 16 + swz / 64; C = (st & 1) * 32 + (swz % 64) / 2; }
__host__ __device__ __forceinline__ int perm32(int rho) { const int n = rho >> 4, i = rho & 15; return 8 * (i >> 2) + 4 * n + (i & 3); }

struct Unit { int pm, pn; };
struct Gemm { const bf16_t* A; const bf16_t* Bt; int M, N, K; };

struct StaticOrder {
    int nM, nN, nwg, G, c;
    __host__ __device__ void init(int M, int N, int G_, int c_) { nM = M / BM; nN = N / BM; nwg = nM * nN; G = G_; c = c_; }
    __host__ __device__ bool next(int i, Unit& u) const {
        const long L = (long)i * G + c; if (L >= nwg) return false;
        int wgid = (int)L; { const int q = nwg / NXCD, r = nwg % NXCD, xcd = wgid % NXCD, off = wgid / NXCD; wgid = (xcd < r ? xcd * (q + 1) : r * (q + 1) + (xcd - r) * q) + off; }
        const int nig = WGM * nN, gid = wgid / nig, fm = gid * WGM, gsz = (nM - fm) < WGM ? (nM - fm) : WGM;
        u.pm = fm + ((wgid % nig) % gsz); u.pn = (wgid % nig) / gsz; return true;
    }
    __device__ __forceinline__ void a_ready(const Unit&) const {}
    __device__ __forceinline__ void done(const Unit&) const {}
};

__device__ __forceinline__ unsigned cvt_pk_bf16(float lo, float hi) { unsigned r; asm volatile("v_cvt_pk_bf16_f32 %0, %1, %2" : "=v"(r) : "v"(lo), "v"(hi)); return r; }
typedef float f32x2 __attribute__((ext_vector_type(2)));
__device__ __forceinline__ float fast_sigmoid(float x) { return __builtin_amdgcn_rcpf(1.0f + __expf(-x)); }
__device__ __forceinline__ float gelu_tanh(float x) { const float u = 1.5957691216f * (x + 0.044715f * x * x * x); return x * fast_sigmoid(u); }
template <int MODE> struct EpiX {
    static constexpr bool PERM = true, AFTER_DRAIN = false;
    bf16_t* O; int ldc; const float* bias; float* st0; float* st1;
    __device__ __forceinline__ void operator()(const f32x4 (&acc)[2][2][4][2], const Unit& u, int wr, int wc, int fr, int fq) const {
        const int row0 = u.pm * BM + wr * 64 + fr;
        if constexpr (MODE == 1) {
            const int col0 = u.pn * HALF + wc * 32 + 8 * fq;
#pragma unroll
            for (int ai = 0; ai < 2; ++ai)
#pragma unroll
                for (int m = 0; m < 4; ++m) { bf16_t* rowp = O + (size_t)(row0 + ai * HALF + m * 16) * ldc + col0;
                    const f32x4 g0 = acc[ai][0][m][0], g1 = acc[ai][0][m][1], u0 = acc[ai][1][m][0], u1 = acc[ai][1][m][1];
                    float r[8];
#pragma unroll
                    for (int e = 0; e < 4; ++e) { r[e] = g0[e] * fast_sigmoid(g0[e]) * u0[e]; r[4 + e] = g1[e] * fast_sigmoid(g1[e]) * u1[e]; }
                    u32x4 w; w.x = cvt_pk_bf16(r[0], r[1]); w.y = cvt_pk_bf16(r[2], r[3]); w.z = cvt_pk_bf16(r[4], r[5]); w.w = cvt_pk_bf16(r[6], r[7]);
                    *(u32x4*)rowp = w; }
        } else {
            const int col0 = u.pn * BM + wc * 32 + 8 * fq;
            f32x4 bv[2][2];
#pragma unroll
            for (int bj = 0; bj < 2; ++bj)
#pragma unroll
                for (int n = 0; n < 2; ++n) bv[bj][n] = (MODE == 3) ? *(const f32x4*)(bias + col0 + bj * HALF + 4 * n) : (f32x4){0.f, 0.f, 0.f, 0.f};
#pragma unroll
            for (int ai = 0; ai < 2; ++ai)
#pragma unroll
                for (int m = 0; m < 4; ++m) { const int row = row0 + ai * HALF + m * 16; bf16_t* rowp = O + (size_t)row * ldc + col0;
                    float s1 = 0.f, s2 = 0.f;
#pragma unroll
                    for (int bj = 0; bj < 2; ++bj) { f32x4 v0 = acc[ai][bj][m][0], v1 = acc[ai][bj][m][1];
                        if constexpr (MODE == 3) { v0 = v0 + bv[bj][0]; v1 = v1 + bv[bj][1];
#pragma unroll
                            for (int e = 0; e < 4; ++e) { v0[e] = gelu_tanh(v0[e]); v1[e] = gelu_tanh(v1[e]); } }
                        if constexpr (MODE == 2 || MODE == 3) {
#pragma unroll
                            for (int e = 0; e < 4; ++e) { s1 += v0[e] + v1[e]; s2 += v0[e] * v0[e] + v1[e] * v1[e]; } }
                        u32x4 w; w.x = cvt_pk_bf16(v0[0], v0[1]); w.y = cvt_pk_bf16(v0[2], v0[3]); w.z = cvt_pk_bf16(v1[0], v1[1]); w.w = cvt_pk_bf16(v1[2], v1[3]);
                        *(u32x4*)(rowp + bj * HALF) = w; }
                    if constexpr (MODE == 2) { s2 += __shfl_xor(s2, 16); s2 += __shfl_xor(s2, 32); if (fq == 0) st0[(size_t)row * 16 + u.pn * 4 + wc] = s2; }
                    if constexpr (MODE == 3) { if (u.pn >= 4) { s1 += __shfl_xor(s1, 16); s1 += __shfl_xor(s1, 32); s2 += __shfl_xor(s2, 16); s2 += __shfl_xor(s2, 32);
                            if (fq == 0) { st0[(size_t)row * 16 + (u.pn - 4) * 4 + wc] = s1; st1[(size_t)row * 16 + (u.pn - 4) * 4 + wc] = s2; } } }
                }
        }
    }
};
template <class Epi, class Sched, bool ALIGN_EPI = false, bool SP2 = false>
__device__ __forceinline__ void gemm_phase(PG8_LAS unsigned char* lds, const Gemm g, const Sched& S, const Epi& E) {
    int tid_ = threadIdx.x; asm volatile("" : "+v"(tid_));
    const int tid = tid_, wid = __builtin_amdgcn_readfirstlane(tid >> 6), lane = tid & 63, wr = wid >> 2, wc = wid & 3, fr = lane & 15, fq = lane >> 4;
    const int K = g.K, nt = K / BK;
    unsigned voffA[2], voffB[2];
#pragma unroll
    for (int i = 0; i < 2; ++i) { int R, C; stage_rc(tid * 16 + i * 8192, R, C); const int Rb = Epi::PERM ? ((R & ~31) + perm32(R & 31)) : R;
        voffA[i] = (unsigned)(R * K + C) * 2u; voffB[i] = (unsigned)(Rb * K + C) * 2u; }
    const size_t kstep = (size_t)(BK * 2);
    const size_t hstep = (size_t)HALF * K * 2;
    const size_t tstep = 2 * hstep;
    const unsigned ldsw = (unsigned)wid * 1024u;
    const int aoff = lds_byte(wr * 64 + fr, fq * 8), boff = lds_byte(wc * 32 + fr, fq * 8);
#define PG8_SA(b, h) (((b) * 2 + (h)) * HTB)
#define PG8_SB(b, h) ((4 + (b) * 2 + (h)) * HTB)
#define PG8_STAGE(bufoff, gbase, voff) do { _Pragma("unroll") for (int _i = 0; _i < 2; ++_i) \
        __builtin_amdgcn_global_load_lds((const unsigned*)((const char*)(gbase) + (voff)[_i]), (PG8_LAS unsigned*)(lds + (bufoff) + ldsw + _i * 8192), 16, 0, 0); } while (0)
#define PG8_LDA(dst, b, h) do { _Pragma("unroll") for (int m = 0; m < 4; ++m) _Pragma("unroll") for (int k = 0; k < 2; ++k) dst[m][k] = *(const PG8_LAS bf16x8*)(lds + PG8_SA(b, h) + aoff + m * 2048 + k * 1024); } while (0)
#define PG8_LDB(dst, b, h) do { _Pragma("unroll") for (int n = 0; n < 2; ++n) _Pragma("unroll") for (int k = 0; k < 2; ++k) dst[n][k] = *(const PG8_LAS bf16x8*)(lds + PG8_SB(b, h) + boff + n * 2048 + k * 1024); } while (0)
#define PG8_MMA(ai, bj, At, Bt) do { __builtin_amdgcn_s_setprio(1); _Pragma("unroll") for (int m = 0; m < 4; ++m) _Pragma("unroll") for (int n = 0; n < 2; ++n) _Pragma("unroll") for (int k = 0; k < 2; ++k) \
        acc[ai][bj][m][n] = __builtin_amdgcn_mfma_f32_16x16x32_bf16(Bt[n][k], At[m][k], acc[ai][bj][m][n], 0, 0, 0); __builtin_amdgcn_s_setprio(0); } while (0)
#define PG8_WAIT_V(n) asm volatile("s_waitcnt vmcnt(" #n ")" ::: "memory")
#define PG8_WAIT_L(n) asm volatile("s_waitcnt lgkmcnt(" #n ")" ::: "memory")
#define PG8_BAR __builtin_amdgcn_s_barrier()
#define PG8_SCHED __builtin_amdgcn_sched_barrier(0)
    Unit cur, nxt; int ui = 0;
    if (!S.next(0, cur)) return;
    f32x4 acc[2][2][4][2];
#pragma unroll
    for (int a = 0; a < 2; ++a)
#pragma unroll
        for (int b = 0; b < 2; ++b)
#pragma unroll
            for (int m = 0; m < 4; ++m)
#pragma unroll
                for (int n = 0; n < 2; ++n) acc[a][b][m][n] = (f32x4){0.f, 0.f, 0.f, 0.f};
    bf16x8 At[4][2], B0[2][2], B1[2][2];
    const char* cA = (const char*)g.A + (size_t)cur.pm * tstep; const char* cB = (const char*)g.Bt + (size_t)cur.pn * tstep;
    S.a_ready(cur);
    if constexpr (SP2) {
        PG8_STAGE(PG8_SB(0, 0), cB, voffB); PG8_STAGE(PG8_SB(0, 1), cB + hstep, voffB); PG8_STAGE(PG8_SA(0, 0), cA, voffA); PG8_STAGE(PG8_SA(0, 1), cA + hstep, voffA);
        if (wr == 1) PG8_BAR;
        PG8_WAIT_V(2); PG8_BAR;
        PG8_STAGE(PG8_SB(1, 0), cB + kstep, voffB); PG8_STAGE(PG8_SA(1, 0), cA + kstep, voffA); PG8_STAGE(PG8_SB(1, 1), cB + hstep + kstep, voffB);
        PG8_WAIT_V(6); PG8_BAR;
    } else {
        PG8_STAGE(PG8_SB(0, 0), cB, voffB); PG8_STAGE(PG8_SA(0, 0), cA, voffA); PG8_STAGE(PG8_SB(0, 1), cB + hstep, voffB); PG8_STAGE(PG8_SA(0, 1), cA + hstep, voffA);
        if (wr == 1) PG8_BAR;
        PG8_WAIT_V(4); PG8_BAR;
        PG8_STAGE(PG8_SB(1, 0), cB + kstep, voffB); PG8_STAGE(PG8_SA(1, 0), cA + kstep, voffA); PG8_STAGE(PG8_SB(1, 1), cB + hstep + kstep, voffB);
        PG8_WAIT_V(6); PG8_BAR;
    }
    for (;;) {
        const bool has_next = S.next(ui + 1, nxt);
        const char* nA = has_next ? (const char*)g.A + (size_t)nxt.pm * tstep : cA; const char* nB = has_next ? (const char*)g.Bt + (size_t)nxt.pn * tstep : cB;
        for (int t = 0; t < nt; t += 2) {
            const bool last = (t == nt - 2);
            const char* a1 = cA + (size_t)(t + 1) * kstep;
            const char* a2 = last ? nA : cA + (size_t)(t + 2) * kstep; const char* b2 = last ? nB : cB + (size_t)(t + 2) * kstep;
            const char* a3 = a2 + kstep; const char* b3 = b2 + kstep;
            if (last && has_next) S.a_ready(nxt);
            if constexpr (SP2) {
            PG8_LDB(B0, 0, 0); PG8_LDB(B1, 0, 1); PG8_SCHED; PG8_LDA(At, 0, 0); PG8_STAGE(PG8_SA(1, 1), a1 + hstep, voffA);
            PG8_WAIT_V(8); PG8_WAIT_L(0); PG8_BAR; PG8_MMA(0, 0, At, B0); PG8_MMA(0, 1, At, B1); PG8_BAR; PG8_SCHED;
            PG8_LDA(At, 0, 1); PG8_STAGE(PG8_SB(0, 0), b2, voffB); PG8_STAGE(PG8_SB(0, 1), b2 + hstep, voffB); PG8_STAGE(PG8_SA(0, 0), a2, voffA);
            PG8_WAIT_V(8); PG8_WAIT_L(0); PG8_BAR; PG8_MMA(1, 0, At, B0); PG8_MMA(1, 1, At, B1); PG8_BAR; PG8_SCHED;
            PG8_LDB(B0, 1, 0); PG8_LDB(B1, 1, 1); PG8_SCHED; PG8_LDA(At, 1, 0); PG8_STAGE(PG8_SA(0, 1), a2 + hstep, voffA);
            PG8_WAIT_V(8); PG8_WAIT_L(0); PG8_BAR; PG8_MMA(0, 0, At, B0); PG8_MMA(0, 1, At, B1); PG8_BAR; PG8_SCHED;
            PG8_LDA(At, 1, 1); PG8_STAGE(PG8_SB(1, 0), b3, voffB); PG8_STAGE(PG8_SB(1, 1), b3 + hstep, voffB); PG8_STAGE(PG8_SA(1, 0), a3, voffA);
            PG8_WAIT_V(8); PG8_WAIT_L(0); PG8_BAR; PG8_MMA(1, 0, At, B0); PG8_MMA(1, 1, At, B1); PG8_BAR; PG8_SCHED;
            } else {
            PG8_LDB(B0, 0, 0); PG8_SCHED; PG8_LDA(At, 0, 0); PG8_STAGE(PG8_SA(1, 1), a1 + hstep, voffA);
            PG8_WAIT_L(8); PG8_BAR; PG8_WAIT_L(0); PG8_MMA(0, 0, At, B0); PG8_BAR; PG8_SCHED;
            PG8_LDB(B1, 0, 1); PG8_STAGE(PG8_SB(0, 0), b2, voffB);
            PG8_BAR; PG8_WAIT_L(0); PG8_MMA(0, 1, At, B1); PG8_BAR;
            PG8_LDA(At, 0, 1); PG8_STAGE(PG8_SA(0, 0), a2, voffA);
            PG8_BAR; PG8_WAIT_L(0); PG8_MMA(1, 0, At, B0); PG8_BAR; PG8_SCHED;
            PG8_STAGE(PG8_SB(0, 1), b2 + hstep, voffB);
            PG8_WAIT_V(6); PG8_BAR; PG8_MMA(1, 1, At, B1); PG8_BAR;
            PG8_LDB(B0, 1, 0); PG8_SCHED; PG8_LDA(At, 1, 0); PG8_STAGE(PG8_SA(0, 1), a2 + hstep, voffA);
            PG8_WAIT_L(8); PG8_BAR; PG8_WAIT_L(0); PG8_MMA(0, 0, At, B0); PG8_BAR; PG8_SCHED;
            PG8_LDB(B1, 1, 1); PG8_STAGE(PG8_SB(1, 0), b3, voffB);
            PG8_BAR; PG8_WAIT_L(0); PG8_MMA(0, 1, At, B1); PG8_BAR;
            PG8_LDA(At, 1, 1); PG8_STAGE(PG8_SA(1, 0), a3, voffA);
            PG8_BAR; PG8_WAIT_L(0); PG8_MMA(1, 0, At, B0); PG8_BAR; PG8_SCHED;
            PG8_STAGE(PG8_SB(1, 1), b3 + hstep, voffB);
            PG8_WAIT_V(6); PG8_BAR; PG8_MMA(1, 1, At, B1); PG8_BAR;
            }
        }
        if constexpr (ALIGN_EPI) { if (wr == 0) PG8_BAR; }
        if constexpr (!Epi::AFTER_DRAIN) { E(acc, cur, wr, wc, fr, fq); S.done(cur); }
        if (!has_next) break;
#pragma unroll
        for (int a = 0; a < 2; ++a)
#pragma unroll
            for (int b = 0; b < 2; ++b)
#pragma unroll
                for (int m = 0; m < 4; ++m)
#pragma unroll
                    for (int n = 0; n < 2; ++n) acc[a][b][m][n] = (f32x4){0.f, 0.f, 0.f, 0.f};
        cur = nxt; cA = nA; cB = nB; ++ui;
        if constexpr (ALIGN_EPI) { if (wr == 1) PG8_BAR; }
    }
    PG8_WAIT_V(0);
    if constexpr (!ALIGN_EPI) { if (wr == 0) PG8_BAR; }
    PG8_BAR;
    if constexpr (Epi::AFTER_DRAIN) { E.fused(acc, cur, wr, wc, fr, fq, lds, wid, lane); S.done(cur); }
#undef PG8_SA
#undef PG8_SB
#undef PG8_STAGE
#undef PG8_LDA
#undef PG8_LDB
#undef PG8_MMA
#undef PG8_WAIT_V
#undef PG8_WAIT_L
#undef PG8_BAR
#undef PG8_SCHED
}
}
#define GAS __attribute__((address_space(1)))
#define LAS __attribute__((address_space(3)))
typedef unsigned short bf16;
typedef unsigned v4u __attribute__((ext_vector_type(4)));
typedef float f32x4 __attribute__((ext_vector_type(4)));
typedef short bf16x8 __attribute__((ext_vector_type(8)));
typedef GAS unsigned gu32;
typedef GAS unsigned long long gu64;
#define RLX_AGENT __ATOMIC_RELAXED, __HIP_MEMORY_SCOPE_AGENT
#define LDS_WAIT() asm volatile("s_waitcnt lgkmcnt(0)" ::: "memory")
#define VM_WAIT() asm volatile("s_waitcnt vmcnt(0)" ::: "memory")
__device__ __forceinline__ unsigned long long rt() { return __builtin_amdgcn_s_memrealtime(); }
__device__ __forceinline__ unsigned f2bf(float f) { unsigned u = __builtin_bit_cast(unsigned, f); return (u + 0x7fffu + ((u >> 16) & 1u)) >> 16; }
__device__ __forceinline__ unsigned pk2(float lo, float hi) { return f2bf(lo) | (f2bf(hi) << 16); }
#define XB_TMO      128
#define XB_XCNT(j)  (256  + 64 * (j))
#define XB_XSUB(j)  (1280 + 64 * (j))
#define XB_XGEN(j)  (2304 + 64 * (j))
#define XB_TOP      3328
#define XB_TOPGEN   3392
#define XCD_BAR_WORDS 3456
#define XB_SPIN_CAP (1u << 18)

__device__ __forceinline__ unsigned xb_ld(unsigned* p)              { return __hip_atomic_load(p, __ATOMIC_RELAXED, __HIP_MEMORY_SCOPE_AGENT); }
__device__ __forceinline__ unsigned xb_add(unsigned* p, unsigned v) { return __hip_atomic_fetch_add(p, v, __ATOMIC_RELAXED, __HIP_MEMORY_SCOPE_AGENT); }
__device__ __forceinline__ unsigned xb_xcc_id() { return (unsigned)__builtin_amdgcn_s_getreg((3 << 11) | 20) & 0xFu; }
#define XB_SPIN(cond, bar) do { unsigned _sp = 0; while (cond) { __builtin_amdgcn_s_sleep(1); \
    if ((++_sp & 255u) == 0u) { if (xb_ld(&(bar)[XB_TMO])) break; if (_sp > XB_SPIN_CAP) { atomicAdd(&(bar)[XB_TMO], 1u); break; } } } } while (0)

struct XcdBarrier {
    unsigned* bar; unsigned x;
    volatile LAS unsigned* st;
};

__device__ __forceinline__ XcdBarrier xcd_barrier_post(unsigned* bar, volatile LAS unsigned* st) {
    XcdBarrier b; b.bar = bar; b.x = xb_xcc_id(); b.st = st;
    if (threadIdx.x == 0) (void)xb_add(&bar[XB_XCNT(b.x)], 1u);
    return b;
}
__device__ __forceinline__ void xcd_barrier_complete(unsigned* bar, unsigned x, unsigned& nloc, unsigned& nx) {
    const unsigned G = gridDim.x * gridDim.y * gridDim.z;
    unsigned sum, cnt, mine, sp = 0u;
    for (;;) {
        sum = 0u; cnt = 0u; mine = 0u;
#pragma unroll
        for (unsigned j = 0; j < 16; ++j) { const unsigned c = xb_ld(&bar[XB_XCNT(j)]); sum += c; cnt += (c > 0u) ? 1u : 0u; mine = (j == x) ? c : mine; }
        if (sum == G) break;
        __builtin_amdgcn_s_sleep(1);
        if ((++sp & 255u) == 0u) { if (xb_ld(&bar[XB_TMO])) break; if (sp > XB_SPIN_CAP) { atomicAdd(&bar[XB_TMO], 1u); break; } }
    }
    nloc = mine > 0u ? mine : 1u; nx = cnt > 0u ? cnt : 1u;
}

__device__ __forceinline__ void xcd_barrier(const XcdBarrier& b) {
    asm volatile("s_waitcnt vmcnt(0)" ::: "memory");
    __syncthreads();
    if (threadIdx.x == 0) {
        unsigned* bar = b.bar;
        __builtin_amdgcn_s_waitcnt(0);
        unsigned nloc = b.st[0], nx = b.st[1];
        if (nloc == 0u) { xcd_barrier_complete(bar, b.x, nloc, nx); b.st[0] = nloc; b.st[1] = nx; }
        const unsigned old = xb_add(&bar[XB_XSUB(b.x)], 1u);
        const unsigned gen = old / nloc;
        if (old + 1u == (gen + 1u) * nloc) {
            __builtin_amdgcn_fence(__ATOMIC_RELEASE, "agent");
            asm volatile("s_waitcnt vmcnt(0)" ::: "memory");
            const unsigned og = xb_add(&bar[XB_TOP], 1u);
            const unsigned tg = og / nx;
            if (og + 1u == (tg + 1u) * nx) xb_add(&bar[XB_TOPGEN], 1u);
            else XB_SPIN(xb_ld(&bar[XB_TOPGEN]) == tg, bar);
            __builtin_amdgcn_fence(__ATOMIC_ACQUIRE, "agent");
            xb_add(&bar[XB_XGEN(b.x)], 1u);
            asm volatile("s_waitcnt vmcnt(0)" ::: "memory");
        } else {
            XB_SPIN(xb_ld(&bar[XB_XGEN(b.x)]) == gen, bar);
            __builtin_amdgcn_fence(__ATOMIC_ACQUIRE, "agent");
            asm volatile("s_waitcnt vmcnt(0)" ::: "memory");
        }
    }
    __syncthreads();
}

constexpr int NWAVES = 8, NTHR = NWAVES * 64;
constexpr int BATCH = 2, SEQ = 16384, D = 1024, FF = 2816, M = BATCH * SEQ;
constexpr int NCHUNK = M / 128;
constexpr float EPS = 1e-6f;
constexpr size_t MiB = 1u << 20;
constexpr size_t WS_CTL = 0, CTL_ZERO_BYTES = 1 * MiB;
constexpr size_t WS_W = 1 * MiB;
constexpr size_t W13_BYTES = (size_t)2 * FF * D * 2, W2_BYTES = (size_t)D * FF * 2, WIN_BYTES = (size_t)2048 * D * 2, WOUT_BYTES = (size_t)D * D * 2;
constexpr size_t LW_W13 = 0, LW_W2 = 2 * W13_BYTES, LW_WIN = LW_W2 + 2 * W2_BYTES, LW_WOUT = LW_WIN + WIN_BYTES, LAYER_W_BYTES = LW_WOUT + WOUT_BYTES;
static_assert(LAYER_W_BYTES == 39 * MiB, "weights");
constexpr size_t WS_XN = 80 * MiB;
constexpr size_t WS_ACT = 144 * MiB;
constexpr size_t WS_PC = WS_ACT + 128 * MiB;
constexpr size_t WS_Y = 320 * MiB;
constexpr size_t WS_MISC = 384 * MiB;
constexpr size_t WS_ST0 = WS_MISC, WS_ST1 = WS_MISC + 2 * MiB, WS_ST2 = WS_MISC + 4 * MiB;
constexpr size_t WS_MODP = WS_MISC + 6 * MiB;
constexpr size_t WS_PAR = WS_MISC + 11 * MiB;
constexpr size_t WS_WSB = WS_MISC + 12 * MiB;
constexpr size_t WS_GWT = WS_MISC + 12 * MiB + 512 * 1024;
constexpr size_t WS_SUMM = WS_MISC + 13 * MiB;
constexpr size_t WS_XB = WS_MISC + 16 * MiB;
constexpr size_t WS_END = WS_XB + 64 * MiB;
static_assert(WS_W + 2 * LAYER_W_BYTES <= WS_XN && WS_PC + (size_t)M * 512 * 2 <= WS_Y, "d_ws map");
constexpr int CW_BAR = 4096, CW_XRANK = 32768, CW_LBAR = 40960, CW_M1PUB = 53248, CW_M1DONE = 53312;
constexpr int RING_BYTES = 131072, LDS_BYTES = 147456, LDSCTL_OFF = LDS_BYTES - 512, MISC_OFF = LDSCTL_OFF;

struct Args { const float* in[26]; float* out; unsigned char* ws; };
enum { I_X = 0, I_C, I_ADAW, I_ADAB, I_NPRE, I_NPOST, I_W13, I_W2, I_ABWIN, I_ACW, I_ACB, I_AGW, I_AGB, I_ALAM, I_BCW, I_BCB, I_BNG, I_BNB, I_ABWOUT, I_CWIN, I_CBIN, I_CNG, I_CNB, I_CWS, I_CBS, I_CWOUT };

__device__ __forceinline__ float dpp_row_shr(float v, int n) {
    const int iv = __builtin_bit_cast(int, v); int r;
    switch (n) { case 1: r = __builtin_amdgcn_update_dpp(0, iv, 0x111, 0xf, 0xf, true); break; case 2: r = __builtin_amdgcn_update_dpp(0, iv, 0x112, 0xf, 0xf, true); break;
                 case 4: r = __builtin_amdgcn_update_dpp(0, iv, 0x114, 0xf, 0xf, true); break; default: r = __builtin_amdgcn_update_dpp(0, iv, 0x118, 0xf, 0xf, true); break; }
    return __builtin_bit_cast(float, r);
}
__device__ __forceinline__ float row16_sum(float v) {
    v += dpp_row_shr(v, 1); v += dpp_row_shr(v, 2); v += dpp_row_shr(v, 4); v += dpp_row_shr(v, 8);
    return __builtin_bit_cast(float, __builtin_amdgcn_readlane(__builtin_bit_cast(int, v), 15));
}
__device__ __forceinline__ float wave_sum(float v) {
    v += dpp_row_shr(v, 1); v += dpp_row_shr(v, 2); v += dpp_row_shr(v, 4); v += dpp_row_shr(v, 8);
    v += __builtin_bit_cast(float, __builtin_amdgcn_update_dpp(0, __builtin_bit_cast(int, v), 0x142, 0xa, 0xf, false));
    v += __builtin_bit_cast(float, __builtin_amdgcn_update_dpp(0, __builtin_bit_cast(int, v), 0x143, 0xc, 0xf, false));
    return __builtin_bit_cast(float, __builtin_amdgcn_readlane(__builtin_bit_cast(int, v), 63));
}
__device__ __forceinline__ float neg_expm1(float x) {
    const float p = x * (1.0f + x * (0.5f + x * (0.16666667f + x * (0.041666668f + x * (0.0083333338f + x * 0.0013888889f)))));
    return (x > -0.25f) ? -p : 1.0f - __expf(x);
}
__device__ __forceinline__ float bf2f(unsigned h) { return __uint_as_float(h << 16); }
__device__ __forceinline__ float bflo(unsigned w) { return __uint_as_float(w << 16); }
__device__ __forceinline__ float bfhi(unsigned w) { return __uint_as_float(w & 0xffff0000u); }
__device__ __forceinline__ float fsig(float x) { return __builtin_amdgcn_rcpf(1.0f + __expf(-x)); }
__device__ __forceinline__ float gelu_t(float x) { const float u = 1.5957691216f * (x + 0.044715f * x * x * x); return x * fsig(u); }
typedef unsigned u32x2 __attribute__((ext_vector_type(2)));

struct TItem { const float* src; bf16* dst; int K, N; };
__device__ __forceinline__ TItem p0_decode(const Args& args, unsigned char* ws, int it) {
    constexpr int I13 = (D / 64) * (2 * FF / 32), I2 = (FF / 64) * (D / 32), IWIN = (D / 64) * (2048 / 32), IWOUT = (D / 64) * (D / 32);
    const float* W; bf16* WT; int K, N, mode = 0; int r = it;
    if (r < 4 * I13) { const int mi = r / I13; r -= mi * I13; W = args.in[I_W13] + (size_t)mi * D * 2 * FF; K = D; N = 2 * FF; mode = 1; WT = (bf16*)(ws + WS_W + (size_t)(mi >> 1) * LAYER_W_BYTES + LW_W13 + (size_t)(mi & 1) * W13_BYTES); }
    else { r -= 4 * I13;
        if (r < 4 * I2) { const int mi = r / I2; r -= mi * I2; W = args.in[I_W2] + (size_t)mi * FF * D; K = FF; N = D; WT = (bf16*)(ws + WS_W + (size_t)(mi >> 1) * LAYER_W_BYTES + LW_W2 + (size_t)(mi & 1) * W2_BYTES); }
        else { r -= 4 * I2;
            if (r < IWIN) { W = args.in[I_ABWIN]; K = D; N = 2048; WT = (bf16*)(ws + WS_W + LW_WIN); }
            else { r -= IWIN;
                if (r < IWIN) { W = args.in[I_CWIN]; K = D; N = 2048; WT = (bf16*)(ws + WS_W + LAYER_W_BYTES + LW_WIN); }
                else { r -= IWIN;
                    if (r < IWOUT) { W = args.in[I_ABWOUT]; K = D; N = D; WT = (bf16*)(ws + WS_W + LW_WOUT); }
                    else { r -= IWOUT; W = args.in[I_CWOUT]; K = D; N = D; WT = (bf16*)(ws + WS_W + LAYER_W_BYTES + LW_WOUT); } } } } }
    const int nblk = N / 32, kb = r / nblk, nb = r % nblk, k0 = 64 * kb, n0 = 32 * nb;
    int rowbase = n0;
    if (mode == 1) { if (n0 < FF) rowbase = 256 * (n0 >> 7) + (n0 & 127); else { const int c = n0 - FF; rowbase = 256 * (c >> 7) + 128 + (c & 127); } }
    TItem t; t.src = W + (size_t)k0 * N + n0; t.dst = WT + (size_t)rowbase * K + k0; t.K = K; t.N = N; return t;
}
__device__ __forceinline__ void p0_item_load(const TItem& t, int lane, float (&v)[32]) {
#pragma unroll
    for (int i = 0; i < 8; ++i) { const f32x4 q = *(const f32x4*)(t.src + (size_t)(8 * i + (lane >> 3)) * t.N + 4 * (lane & 7)); v[4 * i] = q.x; v[4 * i + 1] = q.y; v[4 * i + 2] = q.z; v[4 * i + 3] = q.w; }
}
__device__ __forceinline__ void p0_item_store(const TItem& t, int lane, const float (&v)[32], LAS float* scr) {
#pragma unroll
    for (int i = 0; i < 8; ++i)
#pragma unroll
        for (int e = 0; e < 4; ++e) scr[(8 * i + (lane >> 3)) * 33 + 4 * (lane & 7) + e] = v[4 * i + e];
    LDS_WAIT(); asm volatile("" ::: "memory");
    const int c = lane & 7;
#pragma unroll
    for (int j = 0; j < 4; ++j) { const int n = (lane >> 3) + 8 * j; const LAS float* s = scr + (8 * c) * 33 + n;
        v4u o; o.x = pk2(s[0 * 33], s[1 * 33]); o.y = pk2(s[2 * 33], s[3 * 33]); o.z = pk2(s[4 * 33], s[5 * 33]); o.w = pk2(s[6 * 33], s[7 * 33]);
        *(GAS v4u*)(t.dst + (size_t)n * t.K + 8 * c) = o; }
    LDS_WAIT(); asm volatile("" ::: "memory");
}

template <bool RES, bool NORM, int XIN, int XOUT>
__device__ __forceinline__ void trans_phase(int gw, int NGW, int lane_, const void* xin_, void* xout_, const bf16* Y, const float* st,
                                            const float* A1p, const float* A2p, const float* A3p, bf16* XN) {
    int lane = lane_; asm volatile("" : "+v"(lane));
    for (int blk = gw; blk < M / 16; blk += NGW) {
        const int rbase = blk * 16, b = rbase / SEQ;
        f32x4 A1[4], A2[4], A3[4];
#pragma unroll
        for (int j = 0; j < 4; ++j) {
            if (RES) A1[j] = *(const f32x4*)(A1p + b * 3072 + 4 * lane + 256 * j);
            if (NORM) { A2[j] = *(const f32x4*)(A2p + b * 3072 + 4 * lane + 256 * j); A3[j] = *(const f32x4*)(A3p + b * 3072 + 4 * lane + 256 * j); }
        }
#pragma unroll 1
        for (int r4 = 0; r4 < 16; r4 += 4) {
            f32x4 xv[4][4]; u32x2 xb[4][4]; u32x2 yv[4][4]; float sp[4];
#pragma unroll
            for (int r = 0; r < 4; ++r) { const size_t row = (size_t)(rbase + r4 + r);
#pragma unroll
                for (int j = 0; j < 4; ++j) { if (XIN == 0) xv[r][j] = *(const f32x4*)((const float*)xin_ + row * D + 4 * lane + 256 * j); else xb[r][j] = *(const u32x2*)((const bf16*)xin_ + row * D + 4 * lane + 256 * j); }
                if (RES) {
#pragma unroll
                    for (int j = 0; j < 4; ++j) yv[r][j] = *(const u32x2*)(Y + row * D + 4 * lane + 256 * j);
                    sp[r] = st[row * 16 + (lane & 15)]; } }
#pragma unroll
            for (int r = 0; r < 4; ++r) { const size_t row = (size_t)(rbase + r4 + r);
                if (XIN == 1) {
#pragma unroll
                    for (int j = 0; j < 4; ++j) xv[r][j] = (f32x4){bflo(xb[r][j].x), bfhi(xb[r][j].x), bflo(xb[r][j].y), bfhi(xb[r][j].y)}; }
                if (RES) {
                    const float ss = row16_sum(sp[r]);
                    const float rstd = rsqrtf(ss * (1.0f / D) + EPS);
#pragma unroll
                    for (int j = 0; j < 4; ++j) { const f32x4 y = (f32x4){bflo(yv[r][j].x), bfhi(yv[r][j].x), bflo(yv[r][j].y), bfhi(yv[r][j].y)};
                        xv[r][j] = xv[r][j] + A1[j] * y * rstd; }
                }
                if (XOUT == 2) {
#pragma unroll
                    for (int j = 0; j < 4; ++j) *(f32x4*)((float*)xout_ + row * D + 4 * lane + 256 * j) = xv[r][j]; }
                if (XOUT == 1) {
#pragma unroll
                    for (int j = 0; j < 4; ++j) { u32x2 w; w.x = pg8::cvt_pk_bf16(xv[r][j].x, xv[r][j].y); w.y = pg8::cvt_pk_bf16(xv[r][j].z, xv[r][j].w);
                        *(u32x2*)((bf16*)xout_ + row * D + 4 * lane + 256 * j) = w; } }
                if (NORM) {
                    float q = 0.f;
#pragma unroll
                    for (int j = 0; j < 4; ++j) q += (xv[r][j].x * xv[r][j].x + xv[r][j].y * xv[r][j].y) + (xv[r][j].z * xv[r][j].z + xv[r][j].w * xv[r][j].w);
                    q = wave_sum(q);
                    const float r2 = rsqrtf(q * (1.0f / D) + EPS);
#pragma unroll
                    for (int j = 0; j < 4; ++j) { const f32x4 h = xv[r][j] * r2 * A2[j] + A3[j];
                        u32x2 w; w.x = pg8::cvt_pk_bf16(h.x, h.y); w.y = pg8::cvt_pk_bf16(h.z, h.w);
                        *(u32x2*)(XN + row * D + 4 * lane + 256 * j) = w; }
                }
            }
        }
    }
}

template <int PASS>
__device__ __forceinline__ void m1_partA(const Args& a, unsigned char* ws, LAS unsigned char* lds, int ci, int w, int lane_) {
    int lane = lane_; asm volatile("" : "+v"(lane));
    const bf16* Z = (const bf16*)(ws + WS_ACT); float* SUMM = (float*)(ws + WS_SUMM); bf16* YCAT = (bf16*)(ws + WS_XN);
    const int ch = w * 64 + lane, row0 = ci * 128; const bool first = (ci % (SEQ / 128)) == 0;
    LAS bf16* xcl = (LAS bf16*)(lds + w * 10752);
    LAS float* gl = (LAS float*)(lds + w * 10752 + 2304);
    const int fr = lane & 15, fq = lane >> 4;
    const bf16* GWT = (const bf16*)(ws + WS_GWT);
    bf16x8 gB[8][2];
#pragma unroll
    for (int et = 0; et < 8; ++et)
#pragma unroll
        for (int ks = 0; ks < 2; ++ks) gB[et][ks] = *(const bf16x8*)(GWT + ((size_t)w * 128 + et * 16 + fr) * 64 + ks * 32 + 8 * fq);
    const float* cwp = a.in[I_ACW];
    const float cw0 = cwp[ch], cw1 = cwp[512 + ch], cw2 = cwp[1024 + ch], cw3 = cwp[1536 + ch], cb = a.in[I_ACB][ch];
    const float lam = a.in[I_ALAM][ch];
    const float c8 = -8.0f * log1pf(expf(-lam));
    const bool small_all = __builtin_amdgcn_ballot_w64(c8 > -0.25f) == ~0ull;
    const float gbr = a.in[I_AGB][w * 128 + lane], gbi = a.in[I_AGB][w * 128 + 64 + lane];
    const bf16* zx = Z + 512 + ch; const bf16* zg = Z + ch;
    float xm3 = 0.f, xm2 = 0.f, xm1 = 0.f;
    if (!first) { xm3 = bf2f(zx[(size_t)(row0 - 3) * 2048]); xm2 = bf2f(zx[(size_t)(row0 - 2) * 2048]); xm1 = bf2f(zx[(size_t)(row0 - 1) * 2048]); }
    float hl = 0.f, P = 1.f;
    if (PASS == 1) { const int c0 = (ci / (SEQ / 128)) * (SEQ / 128);
#pragma unroll 32
        for (int c = c0; c < ci; ++c) { const pg8::f32x2 sm = *(const pg8::f32x2*)(SUMM + ((size_t)c * 512 + ch) * 2); hl = sm.x * hl + sm.y; } }
    unsigned short nx[16], ng[16];
#pragma unroll
    for (int i = 0; i < 16; ++i) { nx[i] = zx[(size_t)(row0 + i) * 2048]; if (PASS == 1) ng[i] = zg[(size_t)(row0 + i) * 2048]; }
#pragma unroll 1
    for (int sc = 0; sc < 8; ++sc) {
        float xc[16]; float ag[16];
#pragma unroll
        for (int i = 0; i < 16; ++i) { const float x = bf2f(nx[i]); xc[i] = cb + cw0 * xm3 + cw1 * xm2 + cw2 * xm1 + cw3 * x; xm3 = xm2; xm2 = xm1; xm1 = x;
            if (PASS == 1) ag[i] = bf2f(ng[i]);
            xcl[i * 72 + lane] = (bf16)f2bf(xc[i]); }
        if (sc < 7) {
#pragma unroll
            for (int i = 0; i < 16; ++i) { nx[i] = zx[(size_t)(row0 + 16 * (sc + 1) + i) * 2048]; if (PASS == 1) ng[i] = zg[(size_t)(row0 + 16 * (sc + 1) + i) * 2048]; } }
        LDS_WAIT(); asm volatile("" ::: "memory");
        f32x4 acc[8];
#pragma unroll
        for (int et = 0; et < 8; ++et) acc[et] = (f32x4){0.f, 0.f, 0.f, 0.f};
#pragma unroll
        for (int ks = 0; ks < 2; ++ks) { const bf16x8 af = *(const LAS bf16x8*)(xcl + fr * 72 + ks * 32 + 8 * fq);
#pragma unroll
            for (int et = 0; et < 8; ++et) acc[et] = __builtin_amdgcn_mfma_f32_16x16x32_bf16(af, gB[et][ks], acc[et], 0, 0, 0); }
#pragma unroll
        for (int et = 0; et < 8; ++et)
#pragma unroll
            for (int r = 0; r < 4; ++r) gl[(4 * fq + r) * 132 + et * 16 + fr] = acc[et][r];
        LDS_WAIT(); asm volatile("" ::: "memory");
#pragma unroll
        for (int i = 0; i < 16; i += 2) {
            typedef pg8::f32x2 v2;
            const v2 gr = (v2){gl[i * 132 + lane], gl[(i + 1) * 132 + lane]} + gbr, gi = (v2){gl[i * 132 + 64 + lane], gl[(i + 1) * 132 + 64 + lane]} + gbi;
            const v2 tr = gr * (-1.4426950408889634f), ti = gi * (-1.4426950408889634f);
            v2 dr, di; dr.x = __builtin_amdgcn_exp2f(tr.x); dr.y = __builtin_amdgcn_exp2f(tr.y); di.x = __builtin_amdgcn_exp2f(ti.x); di.y = __builtin_amdgcn_exp2f(ti.y);
            dr = dr + 1.0f; di = di + 1.0f;
            v2 r, ig; r.x = __builtin_amdgcn_rcpf(dr.x); r.y = __builtin_amdgcn_rcpf(dr.y); ig.x = __builtin_amdgcn_rcpf(di.x); ig.y = __builtin_amdgcn_rcpf(di.y);
            const v2 la = r * c8;
            v2 em;
            if (small_all) { v2 q = la * 0.0013888889f + 0.0083333338f; q = q * la + 0.041666668f; q = q * la + 0.16666667f; q = q * la + 0.5f; q = q * la + 1.0f; em = q * la; }
            else { em.x = __expf(la.x) - 1.0f; em.y = __expf(la.y) - 1.0f; }
            const v2 av = em + 1.0f, m2 = -em * (em + 2.0f);
            v2 mult; mult.x = __builtin_amdgcn_sqrtf(m2.x); mult.y = __builtin_amdgcn_sqrtf(m2.y);
            const v2 uu = mult * ig * (v2){xc[i], xc[i + 1]};
            const float h0 = av.x * hl + uu.x, h1 = av.y * h0 + uu.y; hl = h1;
            if (PASS == 0) P *= av.x * av.y;
            else { const v2 g = (v2){ag[i], ag[i + 1]};
                const v2 tg = (g * g * 0.044715f + 1.0f) * g * (-1.5957691216f * 1.4426950408889634f);
                v2 dg; dg.x = __builtin_amdgcn_exp2f(tg.x); dg.y = __builtin_amdgcn_exp2f(tg.y); dg = dg + 1.0f;
                v2 rg; rg.x = __builtin_amdgcn_rcpf(dg.x); rg.y = __builtin_amdgcn_rcpf(dg.y);
                const v2 y = (v2){h0, h1} * g * rg;
                YCAT[(size_t)(row0 + 16 * sc + i) * 1024 + ch] = (bf16)f2bf(y.x); YCAT[(size_t)(row0 + 16 * sc + i + 1) * 1024 + ch] = (bf16)f2bf(y.y); }
        }
        LDS_WAIT(); asm volatile("" ::: "memory");
    }
    if (PASS == 0)
        __hip_atomic_store((unsigned long long*)(SUMM + ((size_t)ci * 512 + ch) * 2), ((unsigned long long)__float_as_uint(hl) << 32) | (unsigned long long)__float_as_uint(P), __ATOMIC_RELAXED, __HIP_MEMORY_SCOPE_AGENT);
}

__device__ __forceinline__ void m1_partB(const Args& a, unsigned char* ws, int ci, int w, int lane_) {
    int lane = lane_; asm volatile("" : "+v"(lane));
    const bf16* Z = (const bf16*)(ws + WS_ACT); bf16* YCAT = (bf16*)(ws + WS_XN);
    const int ch = w * 64 + lane, row0 = ci * 128; const bool first = (ci % (SEQ / 128)) == 0;
    {
        float bw[31];
#pragma unroll
        for (int k = 0; k < 31; ++k) bw[k] = a.in[I_BCW][k * 512 + ch];
        const float bb = a.in[I_BCB][ch], ng = a.in[I_BNG][ch], nb = a.in[I_BNB][ch];
        const bf16* zv = Z + 1024 + ch; const bf16* zg = Z + 1536 + ch;
        float win[32];
        win[0] = 0.f; win[1] = 0.f;
#pragma unroll
        for (int j = 2; j < 32; ++j) { float v = 0.f; if (!first) { const size_t row = (size_t)(row0 - 32 + j); v = bf2f(zv[row * 2048]) * fsig(bf2f(zg[row * 2048])); } win[j] = v; }
#pragma unroll 1
        for (int base = 0; base < 128; base += 32) {
            unsigned rvg[32];
#pragma unroll
            for (int j = 0; j < 32; ++j) { const size_t row = (size_t)(row0 + base + j); rvg[j] = (unsigned)zv[row * 2048] | ((unsigned)zg[row * 2048] << 16); }
#pragma unroll
            for (int j4 = 0; j4 < 32; j4 += 4) {
                float ac[4], dl[4], vr[4];
#pragma unroll
                for (int q = 0; q < 4; ++q) { const int j = j4 + q; win[j] = bflo(rvg[j]) * fsig(bfhi(rvg[j]));
                    float acc = bb;
#pragma unroll
                    for (int k = 0; k < 31; ++k) acc += bw[k] * win[(j + 2 + k) & 31];
                    ac[q] = acc; }
#pragma unroll
                for (int q = 0; q < 4; ++q) dl[q] = ac[q] - wave_sum(ac[q]) * (1.0f / 64.0f);
#pragma unroll
                for (int q = 0; q < 4; ++q) vr[q] = wave_sum(dl[q] * dl[q]) * (1.0f / 64.0f);
#pragma unroll
                for (int q = 0; q < 4; ++q) { const float y = dl[q] * rsqrtf(vr[q] + EPS) * ng + nb;
                    YCAT[(size_t)(row0 + base + j4 + q) * 1024 + 512 + ch] = (bf16)f2bf(y * fsig(y)); }
            }
        }
    }
}

__device__ __forceinline__ void sg_chunk(const Args& a, unsigned char* ws, LAS unsigned char* lds, int ci, int w, int lane_, int tid_) {
    int lane = lane_, tid = tid_; asm volatile("" : "+v"(lane), "+v"(tid));
    const bf16* Z = (const bf16*)(ws + WS_ACT); bf16* UG = (bf16*)(ws + WS_XN); const bf16* WSB = (const bf16*)(ws + WS_WSB);
    const float* S1 = (const float*)(ws + WS_ST1); const float* S2 = (const float*)(ws + WS_ST2);
    LAS float* sm = (LAS float*)lds;
    LAS bf16* vT = (LAS bf16*)(lds + 1024 + w * 17408);
    const int row0 = ci * 128;
    if (tid < 128) { const size_t row = (size_t)(row0 + tid); float s1 = 0.f, s2 = 0.f;
#pragma unroll
        for (int i = 0; i < 4; ++i) { const f32x4 p = *(const f32x4*)(S1 + row * 16 + 4 * i), q = *(const f32x4*)(S2 + row * 16 + 4 * i); s1 += (p.x + p.y) + (p.z + p.w); s2 += (q.x + q.y) + (q.z + q.w); }
        const float mean = s1 * (1.0f / 1024.0f), var = s2 * (1.0f / 1024.0f) - mean * mean;
        sm[2 * tid] = mean; sm[2 * tid + 1] = rsqrtf(var + EPS); }
    __syncthreads();
    const int fr = lane & 15, fq = lane >> 4;
    bf16x8 yfr[8][4];
#pragma unroll
    for (int tt = 0; tt < 8; ++tt)
#pragma unroll
        for (int ks = 0; ks < 4; ++ks) if (ks < tt / 2 + 1) yfr[tt][ks] = *(const bf16x8*)(WSB + ((size_t)w * 128 + tt * 16 + fr) * 128 + ks * 32 + 8 * fq);
#pragma unroll 1
    for (int hh = 0; hh < 2; ++hh) {
        const int cbase = w * 128 + hh * 64;
        { const int csub = (lane & 7) * 8, sl = lane >> 3;
            float g8[8], b8[8];
#pragma unroll
            for (int e = 0; e < 8; ++e) { g8[e] = a.in[I_CNG][cbase + csub + e]; b8[e] = a.in[I_CNB][cbase + csub + e]; }
#pragma unroll 1
            for (int i0 = 0; i0 < 16; i0 += 8) {
                v4u raw[8];
#pragma unroll
                for (int i = 0; i < 8; ++i) raw[i] = *(const v4u*)(Z + (size_t)(row0 + sl + 8 * (i0 + i)) * 2048 + 1024 + cbase + csub);
#pragma unroll
                for (int i = 0; i < 8; ++i) { const int s = sl + 8 * (i0 + i);
                    const float mean = sm[2 * s], rstd = sm[2 * s + 1];
                    const unsigned rw[4] = {raw[i].x, raw[i].y, raw[i].z, raw[i].w};
#pragma unroll
                    for (int e = 0; e < 8; ++e) { const float v = (e & 1) ? bfhi(rw[e >> 1]) : bflo(rw[e >> 1]);
                        vT[(csub + e) * 136 + (s ^ csub)] = (bf16)f2bf((v - mean) * rstd * g8[e] + b8[e]); } }
            }
        }
        LDS_WAIT(); asm volatile("" ::: "memory");
#pragma unroll
        for (int tt = 0; tt < 8; ++tt) {
            const int t = tt * 16 + fr; const size_t row = (size_t)(row0 + t); const float bs = a.in[I_CBS][w * 128 + t];
            u32x2 uu[4];
#pragma unroll
            for (int ct = 0; ct < 4; ++ct) uu[ct] = *(const u32x2*)(Z + row * 2048 + cbase + ct * 16 + 4 * fq);
            f32x4 acc[4];
#pragma unroll
            for (int ct = 0; ct < 4; ++ct) acc[ct] = (f32x4){0.f, 0.f, 0.f, 0.f};
#pragma unroll
            for (int ks = 0; ks < tt / 2 + 1; ++ks) {
#pragma unroll
                for (int ct = 0; ct < 4; ++ct) { const bf16x8 xf = *(const LAS bf16x8*)(vT + (ct * 16 + fr) * 136 + ((ks * 32 + 8 * fq) ^ (((ct * 16 + fr) >> 3) << 3)));
                    acc[ct] = __builtin_amdgcn_mfma_f32_16x16x32_bf16(xf, yfr[tt][ks], acc[ct], 0, 0, 0); }
            }
#pragma unroll
            for (int ct = 0; ct < 4; ++ct) { const int cc = cbase + ct * 16 + 4 * fq;
                u32x2 o; o.x = pg8::cvt_pk_bf16(bflo(uu[ct].x) * (acc[ct][0] + bs), bfhi(uu[ct].x) * (acc[ct][1] + bs)); o.y = pg8::cvt_pk_bf16(bflo(uu[ct].y) * (acc[ct][2] + bs), bfhi(uu[ct].y) * (acc[ct][3] + bs));
                *(u32x2*)(UG + row * 1024 + cc) = o; }
        }
        LDS_WAIT(); asm volatile("" ::: "memory");
    }
    __syncthreads();
}

__global__ void __launch_bounds__(NTHR, 2) mega_fwd(Args args) {
    extern __shared__ __attribute__((aligned(16))) unsigned char lds_raw[];
    LAS unsigned char* lds = (LAS unsigned char*)lds_raw;
    volatile LAS unsigned* MISC = (volatile LAS unsigned*)(lds + MISC_OFF);
    const int tid = threadIdx.x, lane = tid & 63, wave = __builtin_amdgcn_readfirstlane(tid >> 6);
    const int G = gridDim.x, bx = blockIdx.x;
    const int gw = bx * NWAVES + wave, NGW = G * NWAVES;
    unsigned char* ws = args.ws;
    gu32* ctl = (gu32*)(ws + WS_CTL);
    for (int u = tid; u < (LDS_BYTES - LDSCTL_OFF) / 4; u += NTHR) ((LAS unsigned*)(lds + LDSCTL_OFF))[u] = 0u;
    __syncthreads();
    XcdBarrier bar = xcd_barrier_post((unsigned*)(ctl + CW_BAR), MISC + 8);
#define GRID_BAR() xcd_barrier(bar)
    if (tid == 0) MISC[16] = __hip_atomic_fetch_add((unsigned*)(ctl + CW_XRANK) + 64 * (bar.x & 7u), 1u, __ATOMIC_RELAXED, __HIP_MEMORY_SCOPE_AGENT);
    int cv = bx; bool loc_ok = false;
    unsigned* lb_cnt = (unsigned*)(ctl + CW_LBAR); unsigned* lb_gen = lb_cnt + 64;
#define LOC_BAR() do { if (loc_ok) { \
        asm volatile("s_waitcnt vmcnt(0)" ::: "memory"); __syncthreads(); \
        if (tid == 0) { __builtin_amdgcn_s_waitcnt(0); const unsigned old_ = xb_add(lb_cnt, 1u), g_ = old_ / 4u; \
            if (old_ + 1u == (g_ + 1u) * 4u) xb_add(lb_gen, 1u); \
            else { unsigned sp_ = 0u; while (xb_ld(lb_gen) == g_) { __builtin_amdgcn_s_sleep(1); if (++sp_ > (1u << 24)) break; } } \
            __builtin_amdgcn_fence(__ATOMIC_ACQUIRE, "agent"); asm volatile("s_waitcnt vmcnt(0)" ::: "memory"); } \
        __syncthreads(); } else xcd_barrier(bar); } while (0)

    float* PAR = (float*)(ws + WS_PAR);
    bf16* XB = (bf16*)(ws + WS_XB);
    bf16* XN = (bf16*)(ws + WS_XN); bf16* ACT = (bf16*)(ws + WS_ACT); bf16* YB = (bf16*)(ws + WS_Y);
    float* ST0 = (float*)(ws + WS_ST0); float* ST1 = (float*)(ws + WS_ST1); float* ST2 = (float*)(ws + WS_ST2);
#define PARP(l, s, q) (PAR + ((size_t)((l) * 3 + (s)) * 2) * 3072 + (q) * 1024)

    {
        { float* MODP = (float*)(ws + WS_MODP); const float* cp = args.in[I_C];
            for (int it = gw; it < 2 * 36 * 32; it += NGW) { const int l = it / 1152, rem = it % 1152, jb = rem / 32, kw = rem % 32;
                const float* wp = args.in[I_ADAW] + ((size_t)l * 1024 + kw * 32) * 9216 + jb * 256 + 4 * lane;
                f32x4 a0 = (f32x4){0.f, 0.f, 0.f, 0.f}, a1 = a0;
#pragma unroll 8
                for (int k = 0; k < 32; ++k) { const f32x4 wv = *(const f32x4*)(wp + (size_t)k * 9216);
                    const float c0 = cp[kw * 32 + k], c1 = cp[1024 + kw * 32 + k];
                    const float s0 = c0 / (1.0f + expf(-c0)), s1 = c1 / (1.0f + expf(-c1));
                    a0 = a0 + wv * s0; a1 = a1 + wv * s1; }
                *(f32x4*)(MODP + ((size_t)(kw * 2 + l) * 2 + 0) * 9216 + jb * 256 + 4 * lane) = a0;
                *(f32x4*)(MODP + ((size_t)(kw * 2 + l) * 2 + 1) * 9216 + jb * 256 + 4 * lane) = a1; } }
    }
    GRID_BAR();
    { bool even = (G == 256);
#pragma unroll
        for (int j = 0; j < 8; ++j) even = even && (__hip_atomic_load((unsigned*)(ctl + CW_XRANK) + 64 * j, __ATOMIC_RELAXED, __HIP_MEMORY_SCOPE_AGENT) == 32u);
        loc_ok = even; if (even) cv = (int)(bar.x & 7u) + 8 * (int)MISC[16];
        cv = __builtin_amdgcn_readfirstlane(cv); }
    const int gm_ = (cv >> 3) & 7, gq_ = cv >> 6;
    const int hp = (G == 256) ? 2 * (16 * (cv & 7) + 8 * (gq_ >> 1) + gm_) + (gq_ & 1) : bx;
    lb_cnt = (unsigned*)(ctl + CW_LBAR) + 128 * (8 * (cv & 7) + gm_); lb_gen = lb_cnt + 64;
    const int gwm = hp * NWAVES + wave;
    {
        const float* MODP = (const float*)(ws + WS_MODP);
        const int per = (2 * 3 * 2 * 1024 + G - 1) / G;
        for (int t = bx * per + tid; tid < per && t < 2 * 3 * 2 * 1024 && t < (bx + 1) * per; t += NTHR) {
            const int c = t & 1023, b = (t >> 10) & 1, ls = t >> 11, l = ls / 3, s = ls % 3;
            float v[3];
#pragma unroll
            for (int q = 0; q < 3; ++q) { float pv[32];
#pragma unroll
                for (int kw = 0; kw < 32; ++kw) pv[kw] = MODP[((size_t)(kw * 2 + l) * 2 + b) * 9216 + s * 3072 + q * 1024 + c];
                float acc = args.in[I_ADAB][l * 9216 + s * 3072 + q * 1024 + c];
#pragma unroll
                for (int kw = 0; kw < 32; ++kw) acc += pv[kw];
                v[q] = acc; }
            const float resw = (s == 1) ? 1.0f : 0.5f;
            float* p = PAR + ((size_t)(l * 3 + s) * 2 + b) * 3072 + c;
            p[0] = resw * (1.0f + v[2]) * args.in[I_NPOST][(l * 3 + s) * 1024 + c];
            p[1024] = args.in[I_NPRE][(l * 3 + s) * 1024 + c] * (1.0f + v[1]);
            p[2048] = v[0];
        }
    }
    {
        LAS float* scr = (LAS float*)(lds + wave * 16384);
        constexpr int NITEMS = 4 * (D / 64) * (2 * FF / 32) + 4 * (FF / 64) * (D / 32) + 2 * (D / 64) * (2048 / 32) + 2 * (D / 64) * (D / 32);
        if (gw < NITEMS) {
            TItem cur = p0_decode(args, ws, gw); float v[32]; p0_item_load(cur, lane, v);
#pragma unroll 1
            for (int it = gw; it < NITEMS; it += NGW) {
                const int nit = it + NGW; const bool more = nit < NITEMS;
                TItem nxt = cur; float vn[32];
                if (more) { nxt = p0_decode(args, ws, nit); p0_item_load(nxt, lane, vn); }
                p0_item_store(cur, lane, v, scr);
                if (more) {
#pragma unroll
                    for (int i = 0; i < 32; ++i) v[i] = vn[i];
                    cur = nxt; }
            }
        }
        { bf16* WSB = (bf16*)(ws + WS_WSB); const float* wsp = args.in[I_CWS];
            for (int e = bx * NTHR + tid; e < 8 * 128 * 128; e += G * NTHR) { const int s = e & 127, t = (e >> 7) & 127; WSB[e] = (bf16)f2bf(s <= t ? wsp[e] : 0.f); } }
        { bf16* GWT = (bf16*)(ws + WS_GWT); const float* gp = args.in[I_AGW];
            for (int e = bx * NTHR + tid; e < 8 * 128 * 64; e += G * NTHR) { const int d = e & 63, ee = (e >> 6) & 127, h = e >> 13; GWT[e] = (bf16)f2bf(gp[((size_t)h * 64 + d) * 128 + ee]); } }
    }
    GRID_BAR();
    trans_phase<false, true, 0, 1>(gwm, NGW, lane, args.in[I_X], XB, nullptr, nullptr, nullptr, PARP(0, 0, 1), PARP(0, 0, 2), XN);
    LOC_BAR();

#pragma unroll 1
    for (int l = 0; l < 2; ++l) {
        unsigned char* wl = ws + WS_W + (size_t)l * LAYER_W_BYTES;
#pragma unroll 1
        for (int s = 0; s < 3; ++s) {
            if (s != 1) {
                const int fi = s >> 1;
                if (l == 0 && s == 2) {
                    if (tid == 0) { unsigned sp_ = 0u; while (__hip_atomic_load((unsigned*)(ctl + CW_M1DONE), __ATOMIC_RELAXED, __HIP_MEMORY_SCOPE_AGENT) < (unsigned)G) { __builtin_amdgcn_s_sleep(2); if (++sp_ > (1u << 24)) break; } }
                    __syncthreads(); }
                { pg8::Gemm g{XN, (const bf16*)(wl + LW_W13 + (size_t)fi * W13_BYTES), M, 2 * FF, D}; pg8::StaticOrder S; S.init(M, 2 * FF, G, cv);
                    pg8::EpiX<1> E{ACT, FF, nullptr, nullptr, nullptr};
                    pg8::gemm_phase<pg8::EpiX<1>, pg8::StaticOrder, true, true>(lds, g, S, E); }
                LOC_BAR();
                { pg8::Gemm g{ACT, (const bf16*)(wl + LW_W2 + (size_t)fi * W2_BYTES), M, D, FF}; pg8::StaticOrder S; S.init(M, D, G, cv);
                    pg8::EpiX<2> E{YB, D, nullptr, ST0, nullptr};
                    pg8::gemm_phase<pg8::EpiX<2>, pg8::StaticOrder, true, true>(lds, g, S, E); }
                LOC_BAR();
            } else if (l == 0) {
                { pg8::Gemm g{XN, (const bf16*)(wl + LW_WIN), M, 2048, D}; pg8::StaticOrder S; S.init(M, 2048, G, cv);
                    pg8::EpiX<0> E{ACT, 2048, nullptr, nullptr, nullptr};
                    pg8::gemm_phase<pg8::EpiX<0>, pg8::StaticOrder, true, true>(lds, g, S, E); }
                GRID_BAR();
                for (int ci = hp; ci < NCHUNK; ci += G) m1_partA<0>(args, ws, lds, ci, wave, lane);
                asm volatile("s_waitcnt vmcnt(0)" ::: "memory"); __syncthreads();
                if (tid == 0) __hip_atomic_fetch_add((unsigned*)(ctl + CW_M1PUB), 1u, __ATOMIC_RELAXED, __HIP_MEMORY_SCOPE_AGENT);
                for (int ci = hp; ci < NCHUNK; ci += G) m1_partB(args, ws, ci, wave, lane);
                if (tid == 0) { unsigned sp_ = 0u; while (__hip_atomic_load((unsigned*)(ctl + CW_M1PUB), __ATOMIC_RELAXED, __HIP_MEMORY_SCOPE_AGENT) < (unsigned)G) { __builtin_amdgcn_s_sleep(2); if (++sp_ > (1u << 24)) break; }
                    __builtin_amdgcn_fence(__ATOMIC_ACQUIRE, "agent"); asm volatile("s_waitcnt vmcnt(0)" ::: "memory"); }
                __syncthreads();
                for (int ci = hp; ci < NCHUNK; ci += G) m1_partA<1>(args, ws, lds, ci, wave, lane);
                asm volatile("s_waitcnt vmcnt(0)" ::: "memory"); __syncthreads();
                if (tid == 0) __hip_atomic_fetch_add((unsigned*)(ctl + CW_M1DONE), 1u, __ATOMIC_RELAXED, __HIP_MEMORY_SCOPE_AGENT);
                LOC_BAR();
                { pg8::Gemm g{XN, (const bf16*)(wl + LW_WOUT), M, D, D}; pg8::StaticOrder S; S.init(M, D, G, cv);
                    pg8::EpiX<2> E{YB, D, nullptr, ST0, nullptr};
                    pg8::gemm_phase<pg8::EpiX<2>, pg8::StaticOrder, true, true>(lds, g, S, E); }
                LOC_BAR();
            } else {
                { pg8::Gemm g{XN, (const bf16*)(wl + LW_WIN), M, 2048, D}; pg8::StaticOrder S; S.init(M, 2048, G, cv);
                    pg8::EpiX<3> E{ACT, 2048, args.in[I_CBIN], ST1, ST2};
                    pg8::gemm_phase<pg8::EpiX<3>, pg8::StaticOrder, true, true>(lds, g, S, E); }
                LOC_BAR();
                for (int ci = hp; ci < NCHUNK; ci += G) sg_chunk(args, ws, lds, ci, wave, lane, tid);
                LOC_BAR();
                { pg8::Gemm g{XN, (const bf16*)(wl + LW_WOUT), M, D, D}; pg8::StaticOrder S; S.init(M, D, G, cv);
                    pg8::EpiX<2> E{YB, D, nullptr, ST0, nullptr};
                    pg8::gemm_phase<pg8::EpiX<2>, pg8::StaticOrder, true, true>(lds, g, S, E); }
                LOC_BAR();
            }
            if (l == 1 && s == 2) trans_phase<true, false, 1, 2>(gwm, NGW, lane, XB, args.out, YB, ST0, PARP(l, s, 0), nullptr, nullptr, nullptr);
            else { const int nl = (s == 2) ? l + 1 : l, ns = (s == 2) ? 0 : s + 1;
                trans_phase<true, true, 1, 1>(gwm, NGW, lane, XB, XB, YB, ST0, PARP(l, s, 0), PARP(nl, ns, 1), PARP(nl, ns, 2), XN);
                LOC_BAR(); }
        }
    }
    cg::this_grid().sync();
}

extern "C" void kernel_launch(void* const* d_in, const int* in_sizes, int n_in, void* d_out, int out_size, void* d_ws, size_t ws_size, hipStream_t stream) {
    static int grid = 0;
    if (grid == 0) {
        if (n_in != 26 || in_sizes[0] != M * D || out_size != M * D || ws_size < WS_END) { fprintf(stderr, "kernel_launch: unexpected shapes (n_in %d, in0 %d, out %d, ws %zu)\n", n_in, n_in > 0 ? in_sizes[0] : -1, out_size, ws_size); grid = -1; return; }
        int dev = 0, cus = 0, per_cu = 0;
        if (hipGetDevice(&dev) != hipSuccess || hipDeviceGetAttribute(&cus, hipDeviceAttributeMultiprocessorCount, dev) != hipSuccess) { grid = -1; return; }
        if (hipFuncSetAttribute((const void*)mega_fwd, hipFuncAttributeMaxDynamicSharedMemorySize, LDS_BYTES) != hipSuccess) { fprintf(stderr, "kernel_launch: hipFuncSetAttribute failed\n"); grid = -1; return; }
        if (hipOccupancyMaxActiveBlocksPerMultiprocessor(&per_cu, (const void*)mega_fwd, NTHR, LDS_BYTES) != hipSuccess || per_cu < 1) { fprintf(stderr, "kernel_launch: occupancy query says %d\n", per_cu); per_cu = 1; }
        (void)hipGetLastError();
        grid = cus;
    }
    if (grid < 0) return;
    (void)hipMemsetAsync((char*)d_ws + WS_CTL, 0, CTL_ZERO_BYTES, stream);
    Args a{};
    for (int i = 0; i < 26; ++i) a.in[i] = (const float*)d_in[i];
    a.out = (float*)d_out; a.ws = (unsigned char*)d_ws;
    void* kargs[] = {&a};
    const hipError_t le = hipLaunchCooperativeKernel((const void*)mega_fwd, dim3(grid), dim3(NTHR), kargs, LDS_BYTES, stream);
    if (le != hipSuccess) fprintf(stderr, "kernel_launch: cooperative launch failed: %s (grid %d)\n", hipGetErrorName(le), grid);
}
```

```cpp
#include <hip/hip_runtime.h>
#include <hip/hip_cooperative_groups.h>
#include <cstdio>
#include <cstdint>
namespace cg = cooperative_groups;
namespace pg8 {
#define PG8_LAS __attribute__((address_space(3)))
typedef unsigned short bf16_t;
typedef short bf16x8 __attribute__((ext_vector_type(8)));
typedef float f32x4 __attribute__((ext_vector_type(4)));
typedef unsigned u32x4 __attribute__((ext_vector_type(4)));
constexpr int BM = 256, BK = 64, HALF = 128, HTB = HALF * BK * 2  , STAGE_BYTES = 8 * HTB, NXCD = 8, WGM = 8;

__host__ __device__ __forceinline__ int lds_byte(int r, int c) { const int st = (r >> 4) * 2 + (c >> 5), rr = r & 15, cc = c & 31, ob = rr * 64 + cc * 2; return st * 1024 + (ob ^ (((ob >> 9) & 1) << 5)); }
__host__ __device__ __forceinline__ void stage_rc(int b, int& R, int& C) { const int st = b / 1024, sb = b % 1024, swz = sb ^ (((sb >> 9) & 1) << 5); R = (st >> 1) * 16 + swz / 64; C = (st & 1) * 32 + (swz % 64) / 2; }
__host__ __device__ __forceinline__ int perm32(int rho) { const int n = rho >> 4, i = rho & 15; return 8 * (i >> 2) + 4 * n + (i & 3); }

struct Unit { int pm, pn; };
struct Gemm { const bf16_t* A; const bf16_t* Bt; int M, N, K; };

struct StaticOrder {
    int nM, nN, nwg, G, c;
    __host__ __device__ void init(int M, int N, int G_, int c_) { nM = M / BM; nN = N / BM; nwg = nM * nN; G = G_; c = c_; }
    __host__ __device__ bool next(int i, Unit& u) const {
        const long L = (long)i * G + c; if (L >= nwg) return false;
        int wgid = (int)L; { const int q = nwg / NXCD, r = nwg % NXCD, xcd = wgid % NXCD, off = wgid / NXCD; wgid = (xcd < r ? xcd * (q + 1) : r * (q + 1) + (xcd - r) * q) + off; }
        const int nig = WGM * nN, gid = wgid / nig, fm = gid * WGM, gsz = (nM - fm) < WGM ? (nM - fm) : WGM;
        u.pm = fm + ((wgid % nig) % gsz); u.pn = (wgid % nig) / gsz; return true;
    }
    __device__ __forceinline__ void a_ready(const Unit&) const {}
    __device__ __forceinline__ void done(const Unit&) const {}
};

__device__ __forceinline__ unsigned cvt_pk_bf16(float lo, float hi) { unsigned r; asm volatile("v_cvt_pk_bf16_f32 %0, %1, %2" : "=v"(r) : "v"(lo), "v"(hi)); return r; }
typedef float f32x2 __attribute__((ext_vector_type(2)));
__device__ __forceinline__ float fast_sigmoid(float x) { return __builtin_amdgcn_rcpf(1.0f + __expf(-x)); }
__device__ __forceinline__ float gelu_tanh(float x) { const float u = 1.5957691216f * (x + 0.044715f * x * x * x); return x * fast_sigmoid(u); }
template <int MODE> struct EpiX {
    static constexpr bool PERM = true, AFTER_DRAIN = false;
    bf16_t* O; int ldc; const float* bias; float* st0; float* st1;
    __device__ __forceinline__ void operator()(const f32x4 (&acc)[2][2][4][2], const Unit& u, int wr, int wc, int fr, int fq) const {
        const int row0 = u.pm * BM + wr * 64 + fr;
        if constexpr (MODE == 1) {
            const int col0 = u.pn * HALF + wc * 32 + 8 * fq;
#pragma unroll
            for (int ai = 0; ai < 2; ++ai)
#pragma unroll
                for (int m = 0; m < 4; ++m) { bf16_t* rowp = O + (size_t)(row0 + ai * HALF + m * 16) * ldc + col0;
                    const f32x4 g0 = acc[ai][0][m][0], g1 = acc[ai][0][m][1], u0 = acc[ai][1][m][0], u1 = acc[ai][1][m][1];
                    float r[8];
#pragma unroll
                    for (int e = 0; e < 4; ++e) { r[e] = g0[e] * fast_sigmoid(g0[e]) * u0[e]; r[4 + e] = g1[e] * fast_sigmoid(g1[e]) * u1[e]; }
                    u32x4 w; w.x = cvt_pk_bf16(r[0], r[1]); w.y = cvt_pk_bf16(r[2], r[3]); w.z = cvt_pk_bf16(r[4], r[5]); w.w = cvt_pk_bf16(r[6], r[7]);
                    *(u32x4*)rowp = w; }
        } else {
            const int col0 = u.pn * BM + wc * 32 + 8 * fq;
            f32x4 bv[2][2];
#pragma unroll
            for (int bj = 0; bj < 2; ++bj)
#pragma unroll
                for (int n = 0; n < 2; ++n) bv[bj][n] = (MODE == 3) ? *(const f32x4*)(bias + col0 + bj * HALF + 4 * n) : (f32x4){0.f, 0.f, 0.f, 0.f};
#pragma unroll
            for (int ai = 0; ai < 2; ++ai)
#pragma unroll
                for (int m = 0; m < 4; ++m) { const int row = row0 + ai * HALF + m * 16; bf16_t* rowp = O + (size_t)row * ldc + col0;
                    float s1 = 0.f, s2 = 0.f;
#pragma unroll
                    for (int bj = 0; bj < 2; ++bj) { f32x4 v0 = acc[ai][bj][m][0], v1 = acc[ai][bj][m][1];
                        if constexpr (MODE == 3) { v0 = v0 + bv[bj][0]; v1 = v1 + bv[bj][1];
#pragma unroll
                            for (int e = 0; e < 4; ++e) { v0[e] = gelu_tanh(v0[e]); v1[e] = gelu_tanh(v1[e]); } }
                        if constexpr (MODE == 2 || MODE == 3) {
#pragma unroll
                            for (int e = 0; e < 4; ++e) { s1 += v0[e] + v1[e]; s2 += v0[e] * v0[e] + v1[e] * v1[e]; } }
                        u32x4 w; w.x = cvt_pk_bf16(v0[0], v0[1]); w.y = cvt_pk_bf16(v0[2], v0[3]); w.z = cvt_pk_bf16(v1[0], v1[1]); w.w = cvt_pk_bf16(v1[2], v1[3]);
                        *(u32x4*)(rowp + bj * HALF) = w; }
                    if constexpr (MODE == 2) { s2 += __shfl_xor(s2, 16); s2 += __shfl_xor(s2, 32); if (fq == 0) st0[(size_t)row * 16 + u.pn * 4 + wc] = s2; }
                    if constexpr (MODE == 3) { if (u.pn >= 4) { s1 += __shfl_xor(s1, 16); s1 += __shfl_xor(s1, 32); s2 += __shfl_xor(s2, 16); s2 += __shfl_xor(s2, 32);
                            if (fq == 0) { st0[(size_t)row * 16 + (u.pn - 4) * 4 + wc] = s1; st1[(size_t)row * 16 + (u.pn - 4) * 4 + wc] = s2; } } }
                }
        }
    }
};
template <class Epi, class Sched, bool ALIGN_EPI = false, bool SP2 = false>
__device__ __forceinline__ void gemm_phase(PG8_LAS unsigned char* lds, const Gemm g, const Sched& S, const Epi& E) {
    int tid_ = threadIdx.x; asm volatile("" : "+v"(tid_));
    const int tid = tid_, wid = __builtin_amdgcn_readfirstlane(tid >> 6), lane = tid & 63, wr = wid >> 2, wc = wid & 3, fr = lane & 15, fq = lane >> 4;
    const int K = g.K, nt = K / BK;
    unsigned voffA[2], voffB[2];
#pragma unroll
    for (int i = 0; i < 2; ++i) { int R, C; stage_rc(tid * 16 + i * 8192, R, C); const int Rb = Epi::PERM ? ((R & ~31) + perm32(R & 31)) : R;
        voffA[i] = (unsigned)(R * K + C) * 2u; voffB[i] = (unsigned)(Rb * K + C) * 2u; }
    const size_t kstep = (size_t)(BK * 2);
    const size_t hstep = (size_t)HALF * K * 2;
    const size_t tstep = 2 * hstep;
    const unsigned ldsw = (unsigned)wid * 1024u;
    const int aoff = lds_byte(wr * 64 + fr, fq * 8), boff = lds_byte(wc * 32 + fr, fq * 8);
#define PG8_SA(b, h) (((b) * 2 + (h)) * HTB)
#define PG8_SB(b, h) ((4 + (b) * 2 + (h)) * HTB)
#define PG8_STAGE(bufoff, gbase, voff) do { _Pragma("unroll") for (int _i = 0; _i < 2; ++_i) \
        __builtin_amdgcn_global_load_lds((const unsigned*)((const char*)(gbase) + (voff)[_i]), (PG8_LAS unsigned*)(lds + (bufoff) + ldsw + _i * 8192), 16, 0, 0); } while (0)
#define PG8_LDA(dst, b, h) do { _Pragma("unroll") for (int m = 0; m < 4; ++m) _Pragma("unroll") for (int k = 0; k < 2; ++k) dst[m][k] = *(const PG8_LAS bf16x8*)(lds + PG8_SA(b, h) + aoff + m * 2048 + k * 1024); } while (0)
#define PG8_LDB(dst, b, h) do { _Pragma("unroll") for (int n = 0; n < 2; ++n) _Pragma("unroll") for (int k = 0; k < 2; ++k) dst[n][k] = *(const PG8_LAS bf16x8*)(lds + PG8_SB(b, h) + boff + n * 2048 + k * 1024); } while (0)
#define PG8_MMA(ai, bj, At, Bt) do { __builtin_amdgcn_s_setprio(1); _Pragma("unroll") for (int m = 0; m < 4; ++m) _Pragma("unroll") for (int n = 0; n < 2; ++n) _Pragma("unroll") for (int k = 0; k < 2; ++k) \
        acc[ai][bj][m][n] = __builtin_amdgcn_mfma_f32_16x16x32_bf16(Bt[n][k], At[m][k], acc[ai][bj][m][n], 0, 0, 0); __builtin_amdgcn_s_setprio(0); } while (0)
#define PG8_WAIT_V(n) asm volatile("s_waitcnt vmcnt(" #n ")" ::: "memory")
#define PG8_WAIT_L(n) asm volatile("s_waitcnt lgkmcnt(" #n ")" ::: "memory")
#define PG8_BAR __builtin_amdgcn_s_barrier()
#define PG8_SCHED __builtin_amdgcn_sched_barrier(0)
    Unit cur, nxt; int ui = 0;
    if (!S.next(0, cur)) return;
    f32x4 acc[2][2][4][2];
#pragma unroll
    for (int a = 0; a < 2; ++a)
#pragma unroll
        for (int b = 0; b < 2; ++b)
#pragma unroll
            for (int m = 0; m < 4; ++m)
#pragma unroll
                for (int n = 0; n < 2; ++n) acc[a][b][m][n] = (f32x4){0.f, 0.f, 0.f, 0.f};
    bf16x8 At[4][2], B0[2][2], B1[2][2];
    const char* cA = (const char*)g.A + (size_t)cur.pm * tstep; const char* cB = (const char*)g.Bt + (size_t)cur.pn * tstep;
    S.a_ready(cur);
    if constexpr (SP2) {
        PG8_STAGE(PG8_SB(0, 0), cB, voffB); PG8_STAGE(PG8_SB(0, 1), cB + hstep, voffB); PG8_STAGE(PG8_SA(0, 0), cA, voffA); PG8_STAGE(PG8_SA(0, 1), cA + hstep, voffA);
        if (wr == 1) PG8_BAR;
        PG8_WAIT_V(2); PG8_BAR;
        PG8_STAGE(PG8_SB(1, 0), cB + kstep, voffB); PG8_STAGE(PG8_SA(1, 0), cA + kstep, voffA); PG8_STAGE(PG8_SB(1, 1), cB + hstep + kstep, voffB);
        PG8_WAIT_V(6); PG8_BAR;
    } else {
        PG8_STAGE(PG8_SB(0, 0), cB, voffB); PG8_STAGE(PG8_SA(0, 0), cA, voffA); PG8_STAGE(PG8_SB(0, 1), cB + hstep, voffB); PG8_STAGE(PG8_SA(0, 1), cA + hstep, voffA);
        if (wr == 1) PG8_BAR;
        PG8_WAIT_V(4); PG8_BAR;
        PG8_STAGE(PG8_SB(1, 0), cB + kstep, voffB); PG8_STAGE(PG8_SA(1, 0), cA + kstep, voffA); PG8_STAGE(PG8_SB(1, 1), cB + hstep + kstep, voffB);
        PG8_WAIT_V(6); PG8_BAR;
    }
    for (;;) {
        const bool has_next = S.next(ui + 1, nxt);
        const char* nA = has_next ? (const char*)g.A + (size_t)nxt.pm * tstep : cA; const char* nB = has_next ? (const char*)g.Bt + (size_t)nxt.pn * tstep : cB;
        for (int t = 0; t < nt; t += 2) {
            const bool last = (t == nt - 2);
            const char* a1 = cA + (size_t)(t + 1) * kstep;
            const char* a2 = last ? nA : cA + (size_t)(t + 2) * kstep; const char* b2 = last ? nB : cB + (size_t)(t + 2) * kstep;
            const char* a3 = a2 + kstep; const char* b3 = b2 + kstep;
            if (last && has_next) S.a_ready(nxt);
            if constexpr (SP2) {
            PG8_LDB(B0, 0, 0); PG8_LDB(B1, 0, 1); PG8_SCHED; PG8_LDA(At, 0, 0); PG8_STAGE(PG8_SA(1, 1), a1 + hstep, voffA);
            PG8_WAIT_V(8); PG8_WAIT_L(0); PG8_BAR; PG8_MMA(0, 0, At, B0); PG8_MMA(0, 1, At, B1); PG8_BAR; PG8_SCHED;
            PG8_LDA(At, 0, 1); PG8_STAGE(PG8_SB(0, 0), b2, voffB); PG8_STAGE(PG8_SB(0, 1), b2 + hstep, voffB); PG8_STAGE(PG8_SA(0, 0), a2, voffA);
            PG8_WAIT_V(8); PG8_WAIT_L(0); PG8_BAR; PG8_MMA(1, 0, At, B0); PG8_MMA(1, 1, At, B1); PG8_BAR; PG8_SCHED;
            PG8_LDB(B0, 1, 0); PG8_LDB(B1, 1, 1); PG8_SCHED; PG8_LDA(At, 1, 0); PG8_STAGE(PG8_SA(0, 1), a2 + hstep, voffA);
            PG8_WAIT_V(8); PG8_WAIT_L(0); PG8_BAR; PG8_MMA(0, 0, At, B0); PG8_MMA(0, 1, At, B1); PG8_BAR; PG8_SCHED;
            PG8_LDA(At, 1, 1); PG8_STAGE(PG8_SB(1, 0), b3, voffB); PG8_STAGE(PG8_SB(1, 1), b3 + hstep, voffB); PG8_STAGE(PG8_SA(1, 0), a3, voffA);
            PG8_WAIT_V(8); PG8_WAIT_L(0); PG8_BAR; PG8_MMA(1, 0, At, B0); PG8_MMA(1, 1, At, B1); PG8_BAR; PG8_SCHED;
            } else {
            PG8_LDB(B0, 0, 0); PG8_SCHED; PG8_LDA(At, 0, 0); PG8_STAGE(PG8_SA(1, 1), a1 + hstep, voffA);
            PG8_WAIT_L(8); PG8_BAR; PG8_WAIT_L(0); PG8_MMA(0, 0, At, B0); PG8_BAR; PG8_SCHED;
            PG8_LDB(B1, 0, 1); PG8_STAGE(PG8_SB(0, 0), b2, voffB);
            PG8_BAR; PG8_WAIT_L(0); PG8_MMA(0, 1, At, B1); PG8_BAR;
            PG8_LDA(At, 0, 1); PG8_STAGE(PG8_SA(0, 0), a2, voffA);
            PG8_BAR; PG8_WAIT_L(0); PG8_MMA(1, 0, At, B0); PG8_BAR; PG8_SCHED;
            PG8_STAGE(PG8_SB(0, 1), b2 + hstep, voffB);
            PG8_WAIT_V(6); PG8_BAR; PG8_MMA(1, 1, At, B1); PG8_BAR;
            PG8_LDB(B0, 1, 0); PG8_SCHED; PG8_LDA(At, 1, 0); PG8_STAGE(PG8_SA(0, 1), a2 + hstep, voffA);
            PG8_WAIT_L(8); PG8_BAR; PG8_WAIT_L(0); PG8_MMA(0, 0, At, B0); PG8_BAR; PG8_SCHED;
            PG8_LDB(B1, 1, 1); PG8_STAGE(PG8_SB(1, 0), b3, voffB);
            PG8_BAR; PG8_WAIT_L(0); PG8_MMA(0, 1, At, B1); PG8_BAR;
            PG8_LDA(At, 1, 1); PG8_STAGE(PG8_SA(1, 0), a3, voffA);
            PG8_BAR; PG8_WAIT_L(0); PG8_MMA(1, 0, At, B0); PG8_BAR; PG8_SCHED;
            PG8_STAGE(PG8_SB(1, 1), b3 + hstep, voffB);
            PG8_WAIT_V(6); PG8_BAR; PG8_MMA(1, 1, At, B1); PG8_BAR;
            }
        }
        if constexpr (ALIGN_EPI) { if (wr == 0) PG8_BAR; }
        if constexpr (!Epi::AFTER_DRAIN) { E(acc, cur, wr, wc, fr, fq); S.done(cur); }
        if (!has_next) break;
#pragma unroll
        for (int a = 0; a < 2; ++a)
#pragma unroll
            for (int b = 0; b < 2; ++b)
#pragma unroll
                for (int m = 0; m < 4; ++m)
#pragma unroll
                    for (int n = 0; n < 2; ++n) acc[a][b][m][n] = (f32x4){0.f, 0.f, 0.f, 0.f};
        cur = nxt; cA = nA; cB = nB; ++ui;
        if constexpr (ALIGN_EPI) { if (wr == 1) PG8_BAR; }
    }
    PG8_WAIT_V(0);
    if constexpr (!ALIGN_EPI) { if (wr == 0) PG8_BAR; }
    PG8_BAR;
    if constexpr (Epi::AFTER_DRAIN) { E.fused(acc, cur, wr, wc, fr, fq, lds, wid, lane); S.done(cur); }
#undef PG8_SA
#undef PG8_SB
#undef PG8_STAGE
#undef PG8_LDA
#undef PG8_LDB
#undef PG8_MMA
#undef PG8_WAIT_V
#undef PG8_WAIT_L
#undef PG8_BAR
#undef PG8_SCHED
}
}
#define GAS __attribute__((address_space(1)))
#define LAS __attribute__((address_space(3)))
typedef unsigned short bf16;
typedef unsigned v4u __attribute__((ext_vector_type(4)));
typedef float f32x4 __attribute__((ext_vector_type(4)));
typedef short bf16x8 __attribute__((ext_vector_type(8)));
typedef GAS unsigned gu32;
typedef GAS unsigned long long gu64;
#define RLX_AGENT __ATOMIC_RELAXED, __HIP_MEMORY_SCOPE_AGENT
#define LDS_WAIT() asm volatile("s_waitcnt lgkmcnt(0)" ::: "memory")
#define VM_WAIT() asm volatile("s_waitcnt vmcnt(0)" ::: "memory")
__device__ __forceinline__ unsigned long long rt() { return __builtin_amdgcn_s_memrealtime(); }
__device__ __forceinline__ unsigned f2bf(float f) { unsigned u = __builtin_bit_cast(unsigned, f); return (u + 0x7fffu + ((u >> 16) & 1u)) >> 16; }
__device__ __forceinline__ unsigned pk2(float lo, float hi) { return f2bf(lo) | (f2bf(hi) << 16); }
#define XB_TMO      128
#define XB_XCNT(j)  (256  + 64 * (j))
#define XB_XSUB(j)  (1280 + 64 * (j))
#define XB_XGEN(j)  (2304 + 64 * (j))
#define XB_TOP      3328
#define XB_TOPGEN   3392
#define XCD_BAR_WORDS 3456
#define XB_SPIN_CAP (1u << 18)

__device__ __forceinline__ unsigned xb_ld(unsigned* p)              { return __hip_atomic_load(p, __ATOMIC_RELAXED, __HIP_MEMORY_SCOPE_AGENT); }
__device__ __forceinline__ unsigned xb_add(unsigned* p, unsigned v) { return __hip_atomic_fetch_add(p, v, __ATOMIC_RELAXED, __HIP_MEMORY_SCOPE_AGENT); }
__device__ __forceinline__ unsigned xb_xcc_id() { return (unsigned)__builtin_amdgcn_s_getreg((3 << 11) | 20) & 0xFu; }
#define XB_SPIN(cond, bar) do { unsigned _sp = 0; while (cond) { __builtin_amdgcn_s_sleep(1); \
    if ((++_sp & 255u) == 0u) { if (xb_ld(&(bar)[XB_TMO])) break; if (_sp > XB_SPIN_CAP) { atomicAdd(&(bar)[XB_TMO], 1u); break; } } } } while (0)

struct XcdBarrier {
    unsigned* bar; unsigned x;
    volatile LAS unsigned* st;
};

__device__ __forceinline__ XcdBarrier xcd_barrier_post(unsigned* bar, volatile LAS unsigned* st) {
    XcdBarrier b; b.bar = bar; b.x = xb_xcc_id(); b.st = st;
    if (threadIdx.x == 0) (void)xb_add(&bar[XB_XCNT(b.x)], 1u);
    return b;
}
__device__ __forceinline__ void xcd_barrier_complete(unsigned* bar, unsigned x, unsigned& nloc, unsigned& nx) {
    const unsigned G = gridDim.x * gridDim.y * gridDim.z;
    unsigned sum, cnt, mine, sp = 0u;
    for (;;) {
        sum = 0u; cnt = 0u; mine = 0u;
#pragma unroll
        for (unsigned j = 0; j < 16; ++j) { const unsigned c = xb_ld(&bar[XB_XCNT(j)]); sum += c; cnt += (c > 0u) ? 1u : 0u; mine = (j == x) ? c : mine; }
        if (sum == G) break;
        __builtin_amdgcn_s_sleep(1);
        if ((++sp & 255u) == 0u) { if (xb_ld(&bar[XB_TMO])) break; if (sp > XB_SPIN_CAP) { atomicAdd(&bar[XB_TMO], 1u); break; } }
    }
    nloc = mine > 0u ? mine : 1u; nx = cnt > 0u ? cnt : 1u;
}

__device__ __forceinline__ void xcd_barrier(const XcdBarrier& b) {
    asm volatile("s_waitcnt vmcnt(0)" ::: "memory");
    __syncthreads();
    if (threadIdx.x == 0) {
        unsigned* bar = b.bar;
        __builtin_amdgcn_s_waitcnt(0);
        unsigned nloc = b.st[0], nx = b.st[1];
        if (nloc == 0u) { xcd_barrier_complete(bar, b.x, nloc, nx); b.st[0] = nloc; b.st[1] = nx; }
        const unsigned old = xb_add(&bar[XB_XSUB(b.x)], 1u);
        const unsigned gen = old / nloc;
        if (old + 1u == (gen + 1u) * nloc) {
            __builtin_amdgcn_fence(__ATOMIC_RELEASE, "agent");
            asm volatile("s_waitcnt vmcnt(0)" ::: "memory");
            const unsigned og = xb_add(&bar[XB_TOP], 1u);
            const unsigned tg = og / nx;
            if (og + 1u == (tg + 1u) * nx) xb_add(&bar[XB_TOPGEN], 1u);
            else XB_SPIN(xb_ld(&bar[XB_TOPGEN]) == tg, bar);
            __builtin_amdgcn_fence(__ATOMIC_ACQUIRE, "agent");
            xb_add(&bar[XB_XGEN(b.x)], 1u);
            asm volatile("s_waitcnt vmcnt(0)" ::: "memory");
        } else {
            XB_SPIN(xb_ld(&bar[XB_XGEN(b.x)]) == gen, bar);
            __builtin_amdgcn_fence(__ATOMIC_ACQUIRE, "agent");
            asm volatile("s_waitcnt vmcnt(0)" ::: "memory");
        }
    }
    __syncthreads();
}

constexpr int NWAVES = 8, NTHR = NWAVES * 64;
constexpr int BATCH = 2, SEQ = 16384, D = 1024, FF = 2816, M = BATCH * SEQ;
constexpr int NCHUNK = M / 128;
constexpr float EPS = 1e-6f;
constexpr size_t MiB = 1u << 20;
constexpr size_t WS_CTL = 0, CTL_ZERO_BYTES = 1 * MiB;
constexpr size_t WS_W = 1 * MiB;
constexpr size_t W13_BYTES = (size_t)2 * FF * D * 2, W2_BYTES = (size_t)D * FF * 2, WIN_BYTES = (size_t)2048 * D * 2, WOUT_BYTES = (size_t)D * D * 2;
constexpr size_t LW_W13 = 0, LW_W2 = 2 * W13_BYTES, LW_WIN = LW_W2 + 2 * W2_BYTES, LW_WOUT = LW_WIN + WIN_BYTES, LAYER_W_BYTES = LW_WOUT + WOUT_BYTES;
static_assert(LAYER_W_BYTES == 39 * MiB, "weights");
constexpr size_t WS_XN = 80 * MiB;
constexpr size_t WS_ACT = 144 * MiB;
constexpr size_t WS_PC = WS_ACT + 128 * MiB;
constexpr size_t WS_Y = 320 * MiB;
constexpr size_t WS_MISC = 384 * MiB;
constexpr size_t WS_ST0 = WS_MISC, WS_ST1 = WS_MISC + 2 * MiB, WS_ST2 = WS_MISC + 4 * MiB;
constexpr size_t WS_MODP = WS_MISC + 6 * MiB;
constexpr size_t WS_PAR = WS_MISC + 11 * MiB;
constexpr size_t WS_WSB = WS_MISC + 12 * MiB;
constexpr size_t WS_GWT = WS_MISC + 12 * MiB + 512 * 1024;
constexpr size_t WS_SUMM = WS_MISC + 13 * MiB;
constexpr size_t WS_XB = WS_MISC + 16 * MiB;
constexpr size_t WS_END = WS_XB + 64 * MiB;
static_assert(WS_W + 2 * LAYER_W_BYTES <= WS_XN && WS_PC + (size_t)M * 512 * 2 <= WS_Y, "d_ws map");
constexpr int CW_BAR = 4096, CW_XRANK = 32768, CW_LBAR = 40960, CW_M1PUB = 53248, CW_M1DONE = 53312;
constexpr int RING_BYTES = 131072, LDS_BYTES = 147456, LDSCTL_OFF = LDS_BYTES - 512, MISC_OFF = LDSCTL_OFF;

struct Args { const float* in[26]; float* out; unsigned char* ws; };
enum { I_X = 0, I_C, I_ADAW, I_ADAB, I_NPRE, I_NPOST, I_W13, I_W2, I_ABWIN, I_ACW, I_ACB, I_AGW, I_AGB, I_ALAM, I_BCW, I_BCB, I_BNG, I_BNB, I_ABWOUT, I_CWIN, I_CBIN, I_CNG, I_CNB, I_CWS, I_CBS, I_CWOUT };

__device__ __forceinline__ float dpp_row_shr(float v, int n) {
    const int iv = __builtin_bit_cast(int, v); int r;
    switch (n) { case 1: r = __builtin_amdgcn_update_dpp(0, iv, 0x111, 0xf, 0xf, true); break; case 2: r = __builtin_amdgcn_update_dpp(0, iv, 0x112, 0xf, 0xf, true); break;
                 case 4: r = __builtin_amdgcn_update_dpp(0, iv, 0x114, 0xf, 0xf, true); break; default: r = __builtin_amdgcn_update_dpp(0, iv, 0x118, 0xf, 0xf, true); break; }
    return __builtin_bit_cast(float, r);
}
__device__ __forceinline__ float row16_sum(float v) {
    v += dpp_row_shr(v, 1); v += dpp_row_shr(v, 2); v += dpp_row_shr(v, 4); v += dpp_row_shr(v, 8);
    return __builtin_bit_cast(float, __builtin_amdgcn_readlane(__builtin_bit_cast(int, v), 15));
}
__device__ __forceinline__ float wave_sum(float v) {
    v += dpp_row_shr(v, 1); v += dpp_row_shr(v, 2); v += dpp_row_shr(v, 4); v += dpp_row_shr(v, 8);
    v += __builtin_bit_cast(float, __builtin_amdgcn_update_dpp(0, __builtin_bit_cast(int, v), 0x142, 0xa, 0xf, false));
    v += __builtin_bit_cast(float, __builtin_amdgcn_update_dpp(0, __builtin_bit_cast(int, v), 0x143, 0xc, 0xf, false));
    return __builtin_bit_cast(float, __builtin_amdgcn_readlane(__builtin_bit_cast(int, v), 63));
}
__device__ __forceinline__ float neg_expm1(float x) {
    const float p = x * (1.0f + x * (0.5f + x * (0.16666667f + x * (0.041666668f + x * (0.0083333338f + x * 0.0013888889f)))));
    return (x > -0.25f) ? -p : 1.0f - __expf(x);
}
__device__ __forceinline__ float bf2f(unsigned h) { return __uint_as_float(h << 16); }
__device__ __forceinline__ float bflo(unsigned w) { return __uint_as_float(w << 16); }
__device__ __forceinline__ float bfhi(unsigned w) { return __uint_as_float(w & 0xffff0000u); }
__device__ __forceinline__ float fsig(float x) { return __builtin_amdgcn_rcpf(1.0f + __expf(-x)); }
__device__ __forceinline__ float gelu_t(float x) { const float u = 1.5957691216f * (x + 0.044715f * x * x * x); return x * fsig(u); }
typedef unsigned u32x2 __attribute__((ext_vector_type(2)));

struct TItem { const float* src; bf16* dst; int K, N; };
__device__ __forceinline__ TItem p0_decode(const Args& args, unsigned char* ws, int it) {
    constexpr int I13 = (D / 64) * (2 * FF / 32), I2 = (FF / 64) * (D / 32), IWIN = (D / 64) * (2048 / 32), IWOUT = (D / 64) * (D / 32);
    const float* W; bf16* WT; int K, N, mode = 0; int r = it;
    if (r < 4 * I13) { const int mi = r / I13; r -= mi * I13; W = args.in[I_W13] + (size_t)mi * D * 2 * FF; K = D; N = 2 * FF; mode = 1; WT = (bf16*)(ws + WS_W + (size_t)(mi >> 1) * LAYER_W_BYTES + LW_W13 + (size_t)(mi & 1) * W13_BYTES); }
    else { r -= 4 * I13;
        if (r < 4 * I2) { const int mi = r / I2; r -= mi * I2; W = args.in[I_W2] + (size_t)mi * FF * D; K = FF; N = D; WT = (bf16*)(ws + WS_W + (size_t)(mi >> 1) * LAYER_W_BYTES + LW_W2 + (size_t)(mi & 1) * W2_BYTES); }
        else { r -= 4 * I2;
            if (r < IWIN) { W = args.in[I_ABWIN]; K = D; N = 2048; WT = (bf16*)(ws + WS_W + LW_WIN); }
            else { r -= IWIN;
                if (r < IWIN) { W = args.in[I_CWIN]; K = D; N = 2048; WT = (bf16*)(ws + WS_W + LAYER_W_BYTES + LW_WIN); }
                else { r -= IWIN;
                    if (r < IWOUT) { W = args.in[I_ABWOUT]; K = D; N = D; WT = (bf16*)(ws + WS_W + LW_WOUT); }
                    else { r -= IWOUT; W = args.in[I_CWOUT]; K = D; N = D; WT = (bf16*)(ws + WS_W + LAYER_W_BYTES + LW_WOUT); } } } } }
    const int nblk = N / 32, kb = r / nblk, nb = r % nblk, k0 = 64 * kb, n0 = 32 * nb;
    int rowbase = n0;
    if (mode == 1) { if (n0 < FF) rowbase = 256 * (n0 >> 7) + (n0 & 127); else { const int c = n0 - FF; rowbase = 256 * (c >> 7) + 128 + (c & 127); } }
    TItem t; t.src = W + (size_t)k0 * N + n0; t.dst = WT + (size_t)rowbase * K + k0; t.K = K; t.N = N; return t;
}
__device__ __forceinline__ void p0_item_load(const TItem& t, int lane, float (&v)[32]) {
#pragma unroll
    for (int i = 0; i < 32; ++i) v[i] = t.src[(size_t)(2 * i + (lane >> 5)) * t.N + (lane & 31)];
}
__device__ __forceinline__ void p0_item_store(const TItem& t, int lane, const float (&v)[32], LAS float* scr) {
#pragma unroll
    for (int i = 0; i < 32; ++i) scr[(2 * i + (lane >> 5)) * 33 + (lane & 31)] = v[i];
    LDS_WAIT(); asm volatile("" ::: "memory");
    const int c = lane & 7;
#pragma unroll
    for (int j = 0; j < 4; ++j) { const int n = (lane >> 3) + 8 * j; const LAS float* s = scr + (8 * c) * 33 + n;
        v4u o; o.x = pk2(s[0 * 33], s[1 * 33]); o.y = pk2(s[2 * 33], s[3 * 33]); o.z = pk2(s[4 * 33], s[5 * 33]); o.w = pk2(s[6 * 33], s[7 * 33]);
        *(GAS v4u*)(t.dst + (size_t)n * t.K + 8 * c) = o; }
    LDS_WAIT(); asm volatile("" ::: "memory");
}

template <bool RES, bool NORM, int XIN, int XOUT>
__device__ __forceinline__ void trans_phase(int gw, int NGW, int lane_, const void* xin_, void* xout_, const bf16* Y, const float* st,
                                            const float* A1p, const float* A2p, const float* A3p, bf16* XN) {
    int lane = lane_; asm volatile("" : "+v"(lane));
    for (int blk = gw; blk < M / 16; blk += NGW) {
        const int rbase = blk * 16, b = rbase / SEQ;
        f32x4 A1[4], A2[4], A3[4];
#pragma unroll
        for (int j = 0; j < 4; ++j) {
            if (RES) A1[j] = *(const f32x4*)(A1p + b * 3072 + 4 * lane + 256 * j);
            if (NORM) { A2[j] = *(const f32x4*)(A2p + b * 3072 + 4 * lane + 256 * j); A3[j] = *(const f32x4*)(A3p + b * 3072 + 4 * lane + 256 * j); }
        }
#pragma unroll 1
        for (int r4 = 0; r4 < 16; r4 += 4) {
            f32x4 xv[4][4]; u32x2 xb[4][4]; u32x2 yv[4][4]; float sp[4];
#pragma unroll
            for (int r = 0; r < 4; ++r) { const size_t row = (size_t)(rbase + r4 + r);
#pragma unroll
                for (int j = 0; j < 4; ++j) { if (XIN == 0) xv[r][j] = *(const f32x4*)((const float*)xin_ + row * D + 4 * lane + 256 * j); else xb[r][j] = __builtin_nontemporal_load((const u32x2*)((const bf16*)xin_ + row * D + 4 * lane + 256 * j)); }
                if (RES) {
#pragma unroll
                    for (int j = 0; j < 4; ++j) yv[r][j] = *(const u32x2*)(Y + row * D + 4 * lane + 256 * j);
                    sp[r] = st[row * 16 + (lane & 15)]; } }
#pragma unroll
            for (int r = 0; r < 4; ++r) { const size_t row = (size_t)(rbase + r4 + r);
                if (XIN == 1) {
#pragma unroll
                    for (int j = 0; j < 4; ++j) xv[r][j] = (f32x4){bflo(xb[r][j].x), bfhi(xb[r][j].x), bflo(xb[r][j].y), bfhi(xb[r][j].y)}; }
                if (RES) {
                    const float ss = row16_sum(sp[r]);
                    const float rstd = rsqrtf(ss * (1.0f / D) + EPS);
#pragma unroll
                    for (int j = 0; j < 4; ++j) { const f32x4 y = (f32x4){bflo(yv[r][j].x), bfhi(yv[r][j].x), bflo(yv[r][j].y), bfhi(yv[r][j].y)};
                        xv[r][j] = xv[r][j] + A1[j] * y * rstd; }
                }
                if (XOUT == 2) {
#pragma unroll
                    for (int j = 0; j < 4; ++j) *(f32x4*)((float*)xout_ + row * D + 4 * lane + 256 * j) = xv[r][j]; }
                if (XOUT == 1) {
#pragma unroll
                    for (int j = 0; j < 4; ++j) { u32x2 w; w.x = pg8::cvt_pk_bf16(xv[r][j].x, xv[r][j].y); w.y = pg8::cvt_pk_bf16(xv[r][j].z, xv[r][j].w);
                        __builtin_nontemporal_store(w, (u32x2*)((bf16*)xout_ + row * D + 4 * lane + 256 * j)); } }
                if (NORM) {
                    float q = 0.f;
#pragma unroll
                    for (int j = 0; j < 4; ++j) q += (xv[r][j].x * xv[r][j].x + xv[r][j].y * xv[r][j].y) + (xv[r][j].z * xv[r][j].z + xv[r][j].w * xv[r][j].w);
                    q = wave_sum(q);
                    const float r2 = rsqrtf(q * (1.0f / D) + EPS);
#pragma unroll
                    for (int j = 0; j < 4; ++j) { const f32x4 h = xv[r][j] * r2 * A2[j] + A3[j];
                        u32x2 w; w.x = pg8::cvt_pk_bf16(h.x, h.y); w.y = pg8::cvt_pk_bf16(h.z, h.w);
                        *(u32x2*)(XN + row * D + 4 * lane + 256 * j) = w; }
                }
            }
        }
    }
}

template <int PASS>
__device__ __forceinline__ void m1_partA(const Args& a, unsigned char* ws, LAS unsigned char* lds, int ci, int w, int lane_) {
    int lane = lane_; asm volatile("" : "+v"(lane));
    const bf16* Z = (const bf16*)(ws + WS_ACT); float* SUMM = (float*)(ws + WS_SUMM); bf16* YCAT = (bf16*)(ws + WS_XN);
    const int ch = w * 64 + lane, row0 = ci * 128; const bool first = (ci % (SEQ / 128)) == 0;
    LAS bf16* xcl = (LAS bf16*)(lds + w * 10752);
    LAS float* gl = (LAS float*)(lds + w * 10752 + 2304);
    const int fr = lane & 15, fq = lane >> 4;
    const bf16* GWT = (const bf16*)(ws + WS_GWT);
    bf16x8 gB[8][2];
#pragma unroll
    for (int et = 0; et < 8; ++et)
#pragma unroll
        for (int ks = 0; ks < 2; ++ks) gB[et][ks] = *(const bf16x8*)(GWT + ((size_t)w * 128 + et * 16 + fr) * 64 + ks * 32 + 8 * fq);
    const float* cwp = a.in[I_ACW];
    const float cw0 = cwp[ch], cw1 = cwp[512 + ch], cw2 = cwp[1024 + ch], cw3 = cwp[1536 + ch], cb = a.in[I_ACB][ch];
    const float lam = a.in[I_ALAM][ch];
    const float c8 = -8.0f * log1pf(expf(-lam));
    const bool small_all = __builtin_amdgcn_ballot_w64(c8 > -0.25f) == ~0ull;
    const float gbr = a.in[I_AGB][w * 128 + lane], gbi = a.in[I_AGB][w * 128 + 64 + lane];
    const bf16* zx = Z + 512 + ch; const bf16* zg = Z + ch;
    float xm3 = 0.f, xm2 = 0.f, xm1 = 0.f;
    if (!first) { xm3 = bf2f(zx[(size_t)(row0 - 3) * 2048]); xm2 = bf2f(zx[(size_t)(row0 - 2) * 2048]); xm1 = bf2f(zx[(size_t)(row0 - 1) * 2048]); }
    float hl = 0.f, P = 1.f;
    if (PASS == 1) { const int c0 = (ci / (SEQ / 128)) * (SEQ / 128);
#pragma unroll 32
        for (int c = c0; c < ci; ++c) { const pg8::f32x2 sm = *(const pg8::f32x2*)(SUMM + ((size_t)c * 512 + ch) * 2); hl = sm.x * hl + sm.y; } }
    unsigned short nx[16], ng[16];
#pragma unroll
    for (int i = 0; i < 16; ++i) { nx[i] = zx[(size_t)(row0 + i) * 2048]; if (PASS == 1) ng[i] = zg[(size_t)(row0 + i) * 2048]; }
#pragma unroll 1
    for (int sc = 0; sc < 8; ++sc) {
        float xc[16]; float ag[16];
#pragma unroll
        for (int i = 0; i < 16; ++i) { const float x = bf2f(nx[i]); xc[i] = cb + cw0 * xm3 + cw1 * xm2 + cw2 * xm1 + cw3 * x; xm3 = xm2; xm2 = xm1; xm1 = x;
            if (PASS == 1) ag[i] = bf2f(ng[i]);
            xcl[i * 72 + lane] = (bf16)f2bf(xc[i]); }
        if (sc < 7) {
#pragma unroll
            for (int i = 0; i < 16; ++i) { nx[i] = zx[(size_t)(row0 + 16 * (sc + 1) + i) * 2048]; if (PASS == 1) ng[i] = zg[(size_t)(row0 + 16 * (sc + 1) + i) * 2048]; } }
        LDS_WAIT(); asm volatile("" ::: "memory");
        f32x4 acc[8];
#pragma unroll
        for (int et = 0; et < 8; ++et) acc[et] = (f32x4){0.f, 0.f, 0.f, 0.f};
#pragma unroll
        for (int ks = 0; ks < 2; ++ks) { const bf16x8 af = *(const LAS bf16x8*)(xcl + fr * 72 + ks * 32 + 8 * fq);
#pragma unroll
            for (int et = 0; et < 8; ++et) acc[et] = __builtin_amdgcn_mfma_f32_16x16x32_bf16(af, gB[et][ks], acc[et], 0, 0, 0); }
#pragma unroll
        for (int et = 0; et < 8; ++et)
#pragma unroll
            for (int r = 0; r < 4; ++r) gl[(4 * fq + r) * 132 + et * 16 + fr] = acc[et][r];
        LDS_WAIT(); asm volatile("" ::: "memory");
#pragma unroll
        for (int i = 0; i < 16; i += 2) {
            typedef pg8::f32x2 v2;
            const v2 gr = (v2){gl[i * 132 + lane], gl[(i + 1) * 132 + lane]} + gbr, gi = (v2){gl[i * 132 + 64 + lane], gl[(i + 1) * 132 + 64 + lane]} + gbi;
            const v2 tr = gr * (-1.4426950408889634f), ti = gi * (-1.4426950408889634f);
            v2 dr, di; dr.x = __builtin_amdgcn_exp2f(tr.x); dr.y = __builtin_amdgcn_exp2f(tr.y); di.x = __builtin_amdgcn_exp2f(ti.x); di.y = __builtin_amdgcn_exp2f(ti.y);
            dr = dr + 1.0f; di = di + 1.0f;
            v2 r, ig; r.x = __builtin_amdgcn_rcpf(dr.x); r.y = __builtin_amdgcn_rcpf(dr.y); ig.x = __builtin_amdgcn_rcpf(di.x); ig.y = __builtin_amdgcn_rcpf(di.y);
            const v2 la = r * c8;
            v2 em;
            if (small_all) { v2 q = la * 0.0013888889f + 0.0083333338f; q = q * la + 0.041666668f; q = q * la + 0.16666667f; q = q * la + 0.5f; q = q * la + 1.0f; em = q * la; }
            else { em.x = __expf(la.x) - 1.0f; em.y = __expf(la.y) - 1.0f; }
            const v2 av = em + 1.0f, m2 = -em * (em + 2.0f);
            v2 mult; mult.x = __builtin_amdgcn_sqrtf(m2.x); mult.y = __builtin_amdgcn_sqrtf(m2.y);
            const v2 uu = mult * ig * (v2){xc[i], xc[i + 1]};
            const float h0 = av.x * hl + uu.x, h1 = av.y * h0 + uu.y; hl = h1;
            if (PASS == 0) P *= av.x * av.y;
            else { const v2 g = (v2){ag[i], ag[i + 1]};
                const v2 tg = (g * g * 0.044715f + 1.0f) * g * (-1.5957691216f * 1.4426950408889634f);
                v2 dg; dg.x = __builtin_amdgcn_exp2f(tg.x); dg.y = __builtin_amdgcn_exp2f(tg.y); dg = dg + 1.0f;
                v2 rg; rg.x = __builtin_amdgcn_rcpf(dg.x); rg.y = __builtin_amdgcn_rcpf(dg.y);
                const v2 y = (v2){h0, h1} * g * rg;
                YCAT[(size_t)(row0 + 16 * sc + i) * 1024 + ch] = (bf16)f2bf(y.x); YCAT[(size_t)(row0 + 16 * sc + i + 1) * 1024 + ch] = (bf16)f2bf(y.y); }
        }
        LDS_WAIT(); asm volatile("" ::: "memory");
    }
    if (PASS == 0)
        __hip_atomic_store((unsigned long long*)(SUMM + ((size_t)ci * 512 + ch) * 2), ((unsigned long long)__float_as_uint(hl) << 32) | (unsigned long long)__float_as_uint(P), __ATOMIC_RELAXED, __HIP_MEMORY_SCOPE_AGENT);
}

__device__ __forceinline__ void m1_partB(const Args& a, unsigned char* ws, int ci, int w, int lane_) {
    int lane = lane_; asm volatile("" : "+v"(lane));
    const bf16* Z = (const bf16*)(ws + WS_ACT); bf16* YCAT = (bf16*)(ws + WS_XN);
    const int ch = w * 64 + lane, row0 = ci * 128; const bool first = (ci % (SEQ / 128)) == 0;
    {
        float bw[31];
#pragma unroll
        for (int k = 0; k < 31; ++k) bw[k] = a.in[I_BCW][k * 512 + ch];
        const float bb = a.in[I_BCB][ch], ng = a.in[I_BNG][ch], nb = a.in[I_BNB][ch];
        const bf16* zv = Z + 1024 + ch; const bf16* zg = Z + 1536 + ch;
        float win[32];
        win[0] = 0.f; win[1] = 0.f;
#pragma unroll
        for (int j = 2; j < 32; ++j) { float v = 0.f; if (!first) { const size_t row = (size_t)(row0 - 32 + j); v = bf2f(zv[row * 2048]) * fsig(bf2f(zg[row * 2048])); } win[j] = v; }
#pragma unroll 1
        for (int base = 0; base < 128; base += 32) {
            unsigned rvg[32];
#pragma unroll
            for (int j = 0; j < 32; ++j) { const size_t row = (size_t)(row0 + base + j); rvg[j] = (unsigned)zv[row * 2048] | ((unsigned)zg[row * 2048] << 16); }
#pragma unroll
            for (int j4 = 0; j4 < 32; j4 += 4) {
                float ac[4], dl[4], vr[4];
#pragma unroll
                for (int q = 0; q < 4; ++q) { const int j = j4 + q; win[j] = bflo(rvg[j]) * fsig(bfhi(rvg[j]));
                    float acc = bb;
#pragma unroll
                    for (int k = 0; k < 31; ++k) acc += bw[k] * win[(j + 2 + k) & 31];
                    ac[q] = acc; }
#pragma unroll
                for (int q = 0; q < 4; ++q) dl[q] = ac[q] - wave_sum(ac[q]) * (1.0f / 64.0f);
#pragma unroll
                for (int q = 0; q < 4; ++q) vr[q] = wave_sum(dl[q] * dl[q]) * (1.0f / 64.0f);
#pragma unroll
                for (int q = 0; q < 4; ++q) { const float y = dl[q] * rsqrtf(vr[q] + EPS) * ng + nb;
                    YCAT[(size_t)(row0 + base + j4 + q) * 1024 + 512 + ch] = (bf16)f2bf(y * fsig(y)); }
            }
        }
    }
}

__device__ __forceinline__ void sg_chunk(const Args& a, unsigned char* ws, LAS unsigned char* lds, int ci, int w, int lane_, int tid_) {
    int lane = lane_, tid = tid_; asm volatile("" : "+v"(lane), "+v"(tid));
    const bf16* Z = (const bf16*)(ws + WS_ACT); bf16* UG = (bf16*)(ws + WS_XN); const bf16* WSB = (const bf16*)(ws + WS_WSB);
    const float* S1 = (const float*)(ws + WS_ST1); const float* S2 = (const float*)(ws + WS_ST2);
    LAS float* sm = (LAS float*)lds;
    LAS bf16* vT = (LAS bf16*)(lds + 1024 + w * 17408);
    const int row0 = ci * 128;
    if (tid < 128) { const size_t row = (size_t)(row0 + tid); float s1 = 0.f, s2 = 0.f;
#pragma unroll
        for (int i = 0; i < 4; ++i) { const f32x4 p = *(const f32x4*)(S1 + row * 16 + 4 * i), q = *(const f32x4*)(S2 + row * 16 + 4 * i); s1 += (p.x + p.y) + (p.z + p.w); s2 += (q.x + q.y) + (q.z + q.w); }
        const float mean = s1 * (1.0f / 1024.0f), var = s2 * (1.0f / 1024.0f) - mean * mean;
        sm[2 * tid] = mean; sm[2 * tid + 1] = rsqrtf(var + EPS); }
    __syncthreads();
    const int fr = lane & 15, fq = lane >> 4;
    bf16x8 yfr[8][4];
#pragma unroll
    for (int tt = 0; tt < 8; ++tt)
#pragma unroll
        for (int ks = 0; ks < 4; ++ks) if (ks < tt / 2 + 1) yfr[tt][ks] = *(const bf16x8*)(WSB + ((size_t)w * 128 + tt * 16 + fr) * 128 + ks * 32 + 8 * fq);
#pragma unroll 1
    for (int hh = 0; hh < 2; ++hh) {
        const int cbase = w * 128 + hh * 64;
        { const int csub = (lane & 7) * 8, sl = lane >> 3;
            float g8[8], b8[8];
#pragma unroll
            for (int e = 0; e < 8; ++e) { g8[e] = a.in[I_CNG][cbase + csub + e]; b8[e] = a.in[I_CNB][cbase + csub + e]; }
#pragma unroll 1
            for (int i0 = 0; i0 < 16; i0 += 8) {
                v4u raw[8];
#pragma unroll
                for (int i = 0; i < 8; ++i) raw[i] = *(const v4u*)(Z + (size_t)(row0 + sl + 8 * (i0 + i)) * 2048 + 1024 + cbase + csub);
#pragma unroll
                for (int i = 0; i < 8; ++i) { const int s = sl + 8 * (i0 + i);
                    const float mean = sm[2 * s], rstd = sm[2 * s + 1];
                    const unsigned rw[4] = {raw[i].x, raw[i].y, raw[i].z, raw[i].w};
#pragma unroll
                    for (int e = 0; e < 8; ++e) { const float v = (e & 1) ? bfhi(rw[e >> 1]) : bflo(rw[e >> 1]);
                        vT[(csub + e) * 136 + (s ^ csub)] = (bf16)f2bf((v - mean) * rstd * g8[e] + b8[e]); } }
            }
        }
        LDS_WAIT(); asm volatile("" ::: "memory");
#pragma unroll
        for (int tt = 0; tt < 8; ++tt) {
            const int t = tt * 16 + fr; const size_t row = (size_t)(row0 + t); const float bs = a.in[I_CBS][w * 128 + t];
            u32x2 uu[4];
#pragma unroll
            for (int ct = 0; ct < 4; ++ct) uu[ct] = *(const u32x2*)(Z + row * 2048 + cbase + ct * 16 + 4 * fq);
            f32x4 acc[4];
#pragma unroll
            for (int ct = 0; ct < 4; ++ct) acc[ct] = (f32x4){0.f, 0.f, 0.f, 0.f};
#pragma unroll
            for (int ks = 0; ks < tt / 2 + 1; ++ks) {
#pragma unroll
                for (int ct = 0; ct < 4; ++ct) { const bf16x8 xf = *(const LAS bf16x8*)(vT + (ct * 16 + fr) * 136 + ((ks * 32 + 8 * fq) ^ (((ct * 16 + fr) >> 3) << 3)));
                    acc[ct] = __builtin_amdgcn_mfma_f32_16x16x32_bf16(xf, yfr[tt][ks], acc[ct], 0, 0, 0); }
            }
#pragma unroll
            for (int ct = 0; ct < 4; ++ct) { const int cc = cbase + ct * 16 + 4 * fq;
                u32x2 o; o.x = pg8::cvt_pk_bf16(bflo(uu[ct].x) * (acc[ct][0] + bs), bfhi(uu[ct].x) * (acc[ct][1] + bs)); o.y = pg8::cvt_pk_bf16(bflo(uu[ct].y) * (acc[ct][2] + bs), bfhi(uu[ct].y) * (acc[ct][3] + bs));
                *(u32x2*)(UG + row * 1024 + cc) = o; }
        }
        LDS_WAIT(); asm volatile("" ::: "memory");
    }
    __syncthreads();
}

__global__ void __launch_bounds__(NTHR, 2) mega_fwd(Args args) {
    extern __shared__ __attribute__((aligned(16))) unsigned char lds_raw[];
    LAS unsigned char* lds = (LAS unsigned char*)lds_raw;
    volatile LAS unsigned* MISC = (volatile LAS unsigned*)(lds + MISC_OFF);
    const int tid = threadIdx.x, lane = tid & 63, wave = __builtin_amdgcn_readfirstlane(tid >> 6);
    const int G = gridDim.x, bx = blockIdx.x;
    const int gw = bx * NWAVES + wave, NGW = G * NWAVES;
    unsigned char* ws = args.ws;
    gu32* ctl = (gu32*)(ws + WS_CTL);
    for (int u = tid; u < (LDS_BYTES - LDSCTL_OFF) / 4; u += NTHR) ((LAS unsigned*)(lds + LDSCTL_OFF))[u] = 0u;
    __syncthreads();
    XcdBarrier bar = xcd_barrier_post((unsigned*)(ctl + CW_BAR), MISC + 8);
#define GRID_BAR() xcd_barrier(bar)
    if (tid == 0) MISC[16] = __hip_atomic_fetch_add((unsigned*)(ctl + CW_XRANK) + 64 * (bar.x & 7u), 1u, __ATOMIC_RELAXED, __HIP_MEMORY_SCOPE_AGENT);
    int cv = bx; bool loc_ok = false;
    unsigned* lb_cnt = (unsigned*)(ctl + CW_LBAR); unsigned* lb_gen = lb_cnt + 64;
#define LOC_BAR() do { if (loc_ok) { \
        asm volatile("s_waitcnt vmcnt(0)" ::: "memory"); __syncthreads(); \
        if (tid == 0) { __builtin_amdgcn_s_waitcnt(0); const unsigned old_ = xb_add(lb_cnt, 1u), g_ = old_ / 4u; \
            if (old_ + 1u == (g_ + 1u) * 4u) xb_add(lb_gen, 1u); \
            else { unsigned sp_ = 0u; while (xb_ld(lb_gen) == g_) { __builtin_amdgcn_s_sleep(1); if (++sp_ > (1u << 24)) break; } } \
            __builtin_amdgcn_fence(__ATOMIC_ACQUIRE, "agent"); asm volatile("s_waitcnt vmcnt(0)" ::: "memory"); } \
        __syncthreads(); } else xcd_barrier(bar); } while (0)

    float* PAR = (float*)(ws + WS_PAR);
    bf16* XB = (bf16*)(ws + WS_XB);
    bf16* XN = (bf16*)(ws + WS_XN); bf16* ACT = (bf16*)(ws + WS_ACT); bf16* YB = (bf16*)(ws + WS_Y);
    float* ST0 = (float*)(ws + WS_ST0); float* ST1 = (float*)(ws + WS_ST1); float* ST2 = (float*)(ws + WS_ST2);
#define PARP(l, s, q) (PAR + ((size_t)((l) * 3 + (s)) * 2) * 3072 + (q) * 1024)

    {
        { float* MODP = (float*)(ws + WS_MODP); const float* cp = args.in[I_C];
            for (int it = gw; it < 2 * 36 * 32; it += NGW) { const int l = it / 1152, rem = it % 1152, jb = rem / 32, kw = rem % 32;
                const float* wp = args.in[I_ADAW] + ((size_t)l * 1024 + kw * 32) * 9216 + jb * 256 + 4 * lane;
                f32x4 a0 = (f32x4){0.f, 0.f, 0.f, 0.f}, a1 = a0;
#pragma unroll 8
                for (int k = 0; k < 32; ++k) { const f32x4 wv = *(const f32x4*)(wp + (size_t)k * 9216);
                    const float c0 = cp[kw * 32 + k], c1 = cp[1024 + kw * 32 + k];
                    const float s0 = c0 / (1.0f + expf(-c0)), s1 = c1 / (1.0f + expf(-c1));
                    a0 = a0 + wv * s0; a1 = a1 + wv * s1; }
                *(f32x4*)(MODP + ((size_t)(kw * 2 + l) * 2 + 0) * 9216 + jb * 256 + 4 * lane) = a0;
                *(f32x4*)(MODP + ((size_t)(kw * 2 + l) * 2 + 1) * 9216 + jb * 256 + 4 * lane) = a1; } }
    }
    GRID_BAR();
    { bool even = (G == 256);
#pragma unroll
        for (int j = 0; j < 8; ++j) even = even && (__hip_atomic_load((unsigned*)(ctl + CW_XRANK) + 64 * j, __ATOMIC_RELAXED, __HIP_MEMORY_SCOPE_AGENT) == 32u);
        loc_ok = even; if (even) cv = (int)(bar.x & 7u) + 8 * (int)MISC[16];
        cv = __builtin_amdgcn_readfirstlane(cv); }
    const int gm_ = (cv >> 3) & 7, gq_ = cv >> 6;
    const int hp = (G == 256) ? 2 * (16 * (cv & 7) + 8 * (gq_ >> 1) + gm_) + (gq_ & 1) : bx;
    lb_cnt = (unsigned*)(ctl + CW_LBAR) + 128 * (8 * (cv & 7) + gm_); lb_gen = lb_cnt + 64;
    const int gwm = hp * NWAVES + wave;
    {
        const float* MODP = (const float*)(ws + WS_MODP);
        const int per = (2 * 3 * 2 * 1024 + G - 1) / G;
        for (int t = bx * per + tid; tid < per && t < 2 * 3 * 2 * 1024 && t < (bx + 1) * per; t += NTHR) {
            const int c = t & 1023, b = (t >> 10) & 1, ls = t >> 11, l = ls / 3, s = ls % 3;
            float v[3];
#pragma unroll
            for (int q = 0; q < 3; ++q) { float pv[32];
#pragma unroll
                for (int kw = 0; kw < 32; ++kw) pv[kw] = MODP[((size_t)(kw * 2 + l) * 2 + b) * 9216 + s * 3072 + q * 1024 + c];
                float acc = args.in[I_ADAB][l * 9216 + s * 3072 + q * 1024 + c];
#pragma unroll
                for (int kw = 0; kw < 32; ++kw) acc += pv[kw];
                v[q] = acc; }
            const float resw = (s == 1) ? 1.0f : 0.5f;
            float* p = PAR + ((size_t)(l * 3 + s) * 2 + b) * 3072 + c;
            p[0] = resw * (1.0f + v[2]) * args.in[I_NPOST][(l * 3 + s) * 1024 + c];
            p[1024] = args.in[I_NPRE][(l * 3 + s) * 1024 + c] * (1.0f + v[1]);
            p[2048] = v[0];
        }
    }
    {
        LAS float* scr = (LAS float*)(lds + wave * 16384);
        constexpr int NITEMS = 4 * (D / 64) * (2 * FF / 32) + 4 * (FF / 64) * (D / 32) + 2 * (D / 64) * (2048 / 32) + 2 * (D / 64) * (D / 32);
        if (gw < NITEMS) {
            TItem cur = p0_decode(args, ws, gw); float v[32]; p0_item_load(cur, lane, v);
#pragma unroll 1
            for (int it = gw; it < NITEMS; it += NGW) {
                const int nit = it + NGW; const bool more = nit < NITEMS;
                TItem nxt = cur; float vn[32];
                if (more) { nxt = p0_decode(args, ws, nit); p0_item_load(nxt, lane, vn); }
                p0_item_store(cur, lane, v, scr);
                if (more) {
#pragma unroll
                    for (int i = 0; i < 32; ++i) v[i] = vn[i];
                    cur = nxt; }
            }
        }
        { bf16* WSB = (bf16*)(ws + WS_WSB); const float* wsp = args.in[I_CWS];
            for (int e = bx * NTHR + tid; e < 8 * 128 * 128; e += G * NTHR) { const int s = e & 127, t = (e >> 7) & 127; WSB[e] = (bf16)f2bf(s <= t ? wsp[e] : 0.f); } }
        { bf16* GWT = (bf16*)(ws + WS_GWT); const float* gp = args.in[I_AGW];
            for (int e = bx * NTHR + tid; e < 8 * 128 * 64; e += G * NTHR) { const int d = e & 63, ee = (e >> 6) & 127, h = e >> 13; GWT[e] = (bf16)f2bf(gp[((size_t)h * 64 + d) * 128 + ee]); } }
    }
    GRID_BAR();
    trans_phase<false, true, 0, 1>(gwm, NGW, lane, args.in[I_X], XB, nullptr, nullptr, nullptr, PARP(0, 0, 1), PARP(0, 0, 2), XN);
    LOC_BAR();

#pragma unroll 1
    for (int l = 0; l < 2; ++l) {
        unsigned char* wl = ws + WS_W + (size_t)l * LAYER_W_BYTES;
#pragma unroll 1
        for (int s = 0; s < 3; ++s) {
            if (s != 1) {
                const int fi = s >> 1;
                if (l == 0 && s == 2) {
                    if (tid == 0) { unsigned sp_ = 0u; while (__hip_atomic_load((unsigned*)(ctl + CW_M1DONE), __ATOMIC_RELAXED, __HIP_MEMORY_SCOPE_AGENT) < (unsigned)G) { __builtin_amdgcn_s_sleep(2); if (++sp_ > (1u << 24)) break; } }
                    __syncthreads(); }
                { pg8::Gemm g{XN, (const bf16*)(wl + LW_W13 + (size_t)fi * W13_BYTES), M, 2 * FF, D}; pg8::StaticOrder S; S.init(M, 2 * FF, G, cv);
                    pg8::EpiX<1> E{ACT, FF, nullptr, nullptr, nullptr};
                    pg8::gemm_phase<pg8::EpiX<1>, pg8::StaticOrder, true, true>(lds, g, S, E); }
                LOC_BAR();
                { pg8::Gemm g{ACT, (const bf16*)(wl + LW_W2 + (size_t)fi * W2_BYTES), M, D, FF}; pg8::StaticOrder S; S.init(M, D, G, cv);
                    pg8::EpiX<2> E{YB, D, nullptr, ST0, nullptr};
                    pg8::gemm_phase<pg8::EpiX<2>, pg8::StaticOrder, true, true>(lds, g, S, E); }
                LOC_BAR();
            } else if (l == 0) {
                { pg8::Gemm g{XN, (const bf16*)(wl + LW_WIN), M, 2048, D}; pg8::StaticOrder S; S.init(M, 2048, G, cv);
                    pg8::EpiX<0> E{ACT, 2048, nullptr, nullptr, nullptr};
                    pg8::gemm_phase<pg8::EpiX<0>, pg8::StaticOrder, true, true>(lds, g, S, E); }
                GRID_BAR();
                for (int ci = hp; ci < NCHUNK; ci += G) m1_partA<0>(args, ws, lds, ci, wave, lane);
                asm volatile("s_waitcnt vmcnt(0)" ::: "memory"); __syncthreads();
                if (tid == 0) __hip_atomic_fetch_add((unsigned*)(ctl + CW_M1PUB), 1u, __ATOMIC_RELAXED, __HIP_MEMORY_SCOPE_AGENT);
                for (int ci = hp; ci < NCHUNK; ci += G) m1_partB(args, ws, ci, wave, lane);
                if (tid == 0) { unsigned sp_ = 0u; while (__hip_atomic_load((unsigned*)(ctl + CW_M1PUB), __ATOMIC_RELAXED, __HIP_MEMORY_SCOPE_AGENT) < (unsigned)G) { __builtin_amdgcn_s_sleep(2); if (++sp_ > (1u << 24)) break; }
                    __builtin_amdgcn_fence(__ATOMIC_ACQUIRE, "agent"); asm volatile("s_waitcnt vmcnt(0)" ::: "memory"); }
                __syncthreads();
                for (int ci = hp; ci < NCHUNK; ci += G) m1_partA<1>(args, ws, lds, ci, wave, lane);
                asm volatile("s_waitcnt vmcnt(0)" ::: "memory"); __syncthreads();
                if (tid == 0) __hip_atomic_fetch_add((unsigned*)(ctl + CW_M1DONE), 1u, __ATOMIC_RELAXED, __HIP_MEMORY_SCOPE_AGENT);
                LOC_BAR();
                { pg8::Gemm g{XN, (const bf16*)(wl + LW_WOUT), M, D, D}; pg8::StaticOrder S; S.init(M, D, G, cv);
                    pg8::EpiX<2> E{YB, D, nullptr, ST0, nullptr};
                    pg8::gemm_phase<pg8::EpiX<2>, pg8::StaticOrder, true, true>(lds, g, S, E); }
                LOC_BAR();
            } else {
                { pg8::Gemm g{XN, (const bf16*)(wl + LW_WIN), M, 2048, D}; pg8::StaticOrder S; S.init(M, 2048, G, cv);
                    pg8::EpiX<3> E{ACT, 2048, args.in[I_CBIN], ST1, ST2};
                    pg8::gemm_phase<pg8::EpiX<3>, pg8::StaticOrder, true, true>(lds, g, S, E); }
                LOC_BAR();
                for (int ci = hp; ci < NCHUNK; ci += G) sg_chunk(args, ws, lds, ci, wave, lane, tid);
                LOC_BAR();
                { pg8::Gemm g{XN, (const bf16*)(wl + LW_WOUT), M, D, D}; pg8::StaticOrder S; S.init(M, D, G, cv);
                    pg8::EpiX<2> E{YB, D, nullptr, ST0, nullptr};
                    pg8::gemm_phase<pg8::EpiX<2>, pg8::StaticOrder, true, true>(lds, g, S, E); }
                LOC_BAR();
            }
            if (l == 1 && s == 2) trans_phase<true, false, 1, 2>(gwm, NGW, lane, XB, args.out, YB, ST0, PARP(l, s, 0), nullptr, nullptr, nullptr);
            else { const int nl = (s == 2) ? l + 1 : l, ns = (s == 2) ? 0 : s + 1;
                trans_phase<true, true, 1, 1>(gwm, NGW, lane, XB, XB, YB, ST0, PARP(l, s, 0), PARP(nl, ns, 1), PARP(nl, ns, 2), XN);
                LOC_BAR(); }
        }
    }
    cg::this_grid().sync();
}

extern "C" void kernel_launch(void* const* d_in, const int* in_sizes, int n_in, void* d_out, int out_size, void* d_ws, size_t ws_size, hipStream_t stream) {
    static int grid = 0;
    if (grid == 0) {
        if (n_in != 26 || in_sizes[0] != M * D || out_size != M * D || ws_size < WS_END) { fprintf(stderr, "kernel_launch: unexpected shapes (n_in %d, in0 %d, out %d, ws %zu)\n", n_in, n_in > 0 ? in_sizes[0] : -1, out_size, ws_size); grid = -1; return; }
        int dev = 0, cus = 0, per_cu = 0;
        if (hipGetDevice(&dev) != hipSuccess || hipDeviceGetAttribute(&cus, hipDeviceAttributeMultiprocessorCount, dev) != hipSuccess) { grid = -1; return; }
        if (hipFuncSetAttribute((const void*)mega_fwd, hipFuncAttributeMaxDynamicSharedMemorySize, LDS_BYTES) != hipSuccess) { fprintf(stderr, "kernel_launch: hipFuncSetAttribute failed\n"); grid = -1; return; }
        if (hipOccupancyMaxActiveBlocksPerMultiprocessor(&per_cu, (const void*)mega_fwd, NTHR, LDS_BYTES) != hipSuccess || per_cu < 1) { fprintf(stderr, "kernel_launch: occupancy query says %d\n", per_cu); per_cu = 1; }
        (void)hipGetLastError();
        grid = cus;
    }
    if (grid < 0) return;
    (void)hipMemsetAsync((char*)d_ws + WS_CTL, 0, CTL_ZERO_BYTES, stream);
    Args a{};
    for (int i = 0; i < 26; ++i) a.in[i] = (const float*)d_in[i];
    a.out = (float*)d_out; a.ws = (unsigned char*)d_ws;
    void* kargs[] = {&a};
    const hipError_t le = hipLaunchCooperativeKernel((const void*)mega_fwd, dim3(grid), dim3(NTHR), kargs, LDS_BYTES, stream);
    if (le != hipSuccess) fprintf(stderr, "kernel_launch: cooperative launch failed: %s (grid %d)\n", hipGetErrorName(le), grid);
}
```

```cpp
#include <hip/hip_runtime.h>
#include <hip/hip_cooperative_groups.h>
#include <cstdio>
#include <cstdint>
namespace cg = cooperative_groups;
namespace pg8 {
#define PG8_LAS __attribute__((address_space(3)))
typedef unsigned short bf16_t;
typedef short bf16x8 __attribute__((ext_vector_type(8)));
typedef float f32x4 __attribute__((ext_vector_type(4)));
typedef unsigned u32x4 __attribute__((ext_vector_type(4)));
constexpr int BM = 256, BK = 64, HALF = 128, HTB = HALF * BK * 2  , STAGE_BYTES = 8 * HTB, NXCD = 8, WGM = 8;

__host__ __device__ __forceinline__ int lds_byte(int r, int c) { const int st = (r >> 4) * 2 + (c >> 5), rr = r & 15, cc = c & 31, ob = rr * 64 + cc * 2; return st * 1024 + (ob ^ (((ob >> 9) & 1) << 5)); }
__host__ __device__ __forceinline__ void stage_rc(int b, int& R, int& C) { const int st = b / 1024, sb = b % 1024, swz = sb ^ (((sb >> 9) & 1) << 5); R = (st >> 1) * 16 + swz / 64; C = (st & 1) * 32 + (swz % 64) / 2; }
__host__ __device__ __forceinline__ int perm32(int rho) { const int n = rho >> 4, i = rho & 15; return 8 * (i >> 2) + 4 * n + (i & 3); }

struct Unit { int pm, pn; };
struct Gemm { const bf16_t* A; const bf16_t* Bt; int M, N, K; };

struct StaticOrder {
    int nM, nN, nwg, G, c;
    __host__ __device__ void init(int M, int N, int G_, int c_) { nM = M / BM; nN = N / BM; nwg = nM * nN; G = G_; c = c_; }
    __host__ __device__ bool next(int i, Unit& u) const {
        const long L = (long)i * G + c; if (L >= nwg) return false;
        int wgid = (int)L; { const int q = nwg / NXCD, r = nwg % NXCD, xcd = wgid % NXCD, off = wgid / NXCD; wgid = (xcd < r ? xcd * (q + 1) : r * (q + 1) + (xcd - r) * q) + off; }
        const int nig = WGM * nN, gid = wgid / nig, fm = gid * WGM, gsz = (nM - fm) < WGM ? (nM - fm) : WGM;
        u.pm = fm + ((wgid % nig) % gsz); u.pn = (wgid % nig) / gsz; return true;
    }
    __device__ __forceinline__ void a_ready(const Unit&) const {}
    __device__ __forceinline__ void done(const Unit&) const {}
};

__device__ __forceinline__ unsigned cvt_pk_bf16(float lo, float hi) { unsigned r; asm volatile("v_cvt_pk_bf16_f32 %0, %1, %2" : "=v"(r) : "v"(lo), "v"(hi)); return r; }
typedef float f32x2 __attribute__((ext_vector_type(2)));
__device__ __forceinline__ float fast_sigmoid(float x) { return __builtin_amdgcn_rcpf(1.0f + __expf(-x)); }
__device__ __forceinline__ float gelu_tanh(float x) { const float u = 1.5957691216f * (x + 0.044715f * x * x * x); return x * fast_sigmoid(u); }
template <int MODE> struct EpiX {
    static constexpr bool PERM = true, AFTER_DRAIN = false;
    bf16_t* O; int ldc; const float* bias; float* st0; float* st1;
    __device__ __forceinline__ void operator()(const f32x4 (&acc)[2][2][4][2], const Unit& u, int wr, int wc, int fr, int fq) const {
        const int row0 = u.pm * BM + wr * 64 + fr;
        if constexpr (MODE == 1) {
            const int col0 = u.pn * HALF + wc * 32 + 8 * fq;
#pragma unroll
            for (int ai = 0; ai < 2; ++ai)
#pragma unroll
                for (int m = 0; m < 4; ++m) { bf16_t* rowp = O + (size_t)(row0 + ai * HALF + m * 16) * ldc + col0;
                    const f32x4 g0 = acc[ai][0][m][0], g1 = acc[ai][0][m][1], u0 = acc[ai][1][m][0], u1 = acc[ai][1][m][1];
                    float r[8];
#pragma unroll
                    for (int e = 0; e < 4; ++e) { r[e] = g0[e] * fast_sigmoid(g0[e]) * u0[e]; r[4 + e] = g1[e] * fast_sigmoid(g1[e]) * u1[e]; }
                    u32x4 w; w.x = cvt_pk_bf16(r[0], r[1]); w.y = cvt_pk_bf16(r[2], r[3]); w.z = cvt_pk_bf16(r[4], r[5]); w.w = cvt_pk_bf16(r[6], r[7]);
                    *(u32x4*)rowp = w; }
        } else {
            const int col0 = u.pn * BM + wc * 32 + 8 * fq;
            f32x4 bv[2][2];
#pragma unroll
            for (int bj = 0; bj < 2; ++bj)
#pragma unroll
                for (int n = 0; n < 2; ++n) bv[bj][n] = (MODE == 3) ? *(const f32x4*)(bias + col0 + bj * HALF + 4 * n) : (f32x4){0.f, 0.f, 0.f, 0.f};
#pragma unroll
            for (int ai = 0; ai < 2; ++ai)
#pragma unroll
                for (int m = 0; m < 4; ++m) { const int row = row0 + ai * HALF + m * 16; bf16_t* rowp = O + (size_t)row * ldc + col0;
                    float s1 = 0.f, s2 = 0.f;
#pragma unroll
                    for (int bj = 0; bj < 2; ++bj) { f32x4 v0 = acc[ai][bj][m][0], v1 = acc[ai][bj][m][1];
                        if constexpr (MODE == 3) { v0 = v0 + bv[bj][0]; v1 = v1 + bv[bj][1];
#pragma unroll
                            for (int e = 0; e < 4; ++e) { v0[e] = gelu_tanh(v0[e]); v1[e] = gelu_tanh(v1[e]); } }
                        if constexpr (MODE == 2 || MODE == 3) {
#pragma unroll
                            for (int e = 0; e < 4; ++e) { s1 += v0[e] + v1[e]; s2 += v0[e] * v0[e] + v1[e] * v1[e]; } }
                        u32x4 w; w.x = cvt_pk_bf16(v0[0], v0[1]); w.y = cvt_pk_bf16(v0[2], v0[3]); w.z = cvt_pk_bf16(v1[0], v1[1]); w.w = cvt_pk_bf16(v1[2], v1[3]);
                        *(u32x4*)(rowp + bj * HALF) = w; }
                    if constexpr (MODE == 2) { s2 += __shfl_xor(s2, 16); s2 += __shfl_xor(s2, 32); if (fq == 0) st0[(size_t)row * 16 + u.pn * 4 + wc] = s2; }
                    if constexpr (MODE == 3) { if (u.pn >= 4) { s1 += __shfl_xor(s1, 16); s1 += __shfl_xor(s1, 32); s2 += __shfl_xor(s2, 16); s2 += __shfl_xor(s2, 32);
                            if (fq == 0) { st0[(size_t)row * 16 + (u.pn - 4) * 4 + wc] = s1; st1[(size_t)row * 16 + (u.pn - 4) * 4 + wc] = s2; } } }
                }
        }
    }
};
template <class Epi, class Sched, bool ALIGN_EPI = false, bool SP2 = false>
__device__ __forceinline__ void gemm_phase(PG8_LAS unsigned char* lds, const Gemm g, const Sched& S, const Epi& E) {
    int tid_ = threadIdx.x; asm volatile("" : "+v"(tid_));
    const int tid = tid_, wid = __builtin_amdgcn_readfirstlane(tid >> 6), lane = tid & 63, wr = wid >> 2, wc = wid & 3, fr = lane & 15, fq = lane >> 4;
    const int K = g.K, nt = K / BK;
    unsigned voffA[2], voffB[2];
#pragma unroll
    for (int i = 0; i < 2; ++i) { int R, C; stage_rc(tid * 16 + i * 8192, R, C); const int Rb = Epi::PERM ? ((R & ~31) + perm32(R & 31)) : R;
        voffA[i] = (unsigned)(R * K + C) * 2u; voffB[i] = (unsigned)(Rb * K + C) * 2u; }
    const size_t kstep = (size_t)(BK * 2);
    const size_t hstep = (size_t)HALF * K * 2;
    const size_t tstep = 2 * hstep;
    const unsigned ldsw = (unsigned)wid * 1024u;
    const int aoff = lds_byte(wr * 64 + fr, fq * 8), boff = lds_byte(wc * 32 + fr, fq * 8);
#define PG8_SA(b, h) (((b) * 2 + (h)) * HTB)
#define PG8_SB(b, h) ((4 + (b) * 2 + (h)) * HTB)
#define PG8_STAGE(bufoff, gbase, voff) do { _Pragma("unroll") for (int _i = 0; _i < 2; ++_i) \
        __builtin_amdgcn_global_load_lds((const unsigned*)((const char*)(gbase) + (voff)[_i]), (PG8_LAS unsigned*)(lds + (bufoff) + ldsw + _i * 8192), 16, 0, 0); } while (0)
#define PG8_LDA(dst, b, h) do { _Pragma("unroll") for (int m = 0; m < 4; ++m) _Pragma("unroll") for (int k = 0; k < 2; ++k) dst[m][k] = *(const PG8_LAS bf16x8*)(lds + PG8_SA(b, h) + aoff + m * 2048 + k * 1024); } while (0)
#define PG8_LDB(dst, b, h) do { _Pragma("unroll") for (int n = 0; n < 2; ++n) _Pragma("unroll") for (int k = 0; k < 2; ++k) dst[n][k] = *(const PG8_LAS bf16x8*)(lds + PG8_SB(b, h) + boff + n * 2048 + k * 1024); } while (0)
#define PG8_MMA(ai, bj, At, Bt) do { __builtin_amdgcn_s_setprio(1); _Pragma("unroll") for (int m = 0; m < 4; ++m) _Pragma("unroll") for (int n = 0; n < 2; ++n) _Pragma("unroll") for (int k = 0; k < 2; ++k) \
        acc[ai][bj][m][n] = __builtin_amdgcn_mfma_f32_16x16x32_bf16(Bt[n][k], At[m][k], acc[ai][bj][m][n], 0, 0, 0); __builtin_amdgcn_s_setprio(0); } while (0)
#define PG8_WAIT_V(n) asm volatile("s_waitcnt vmcnt(" #n ")" ::: "memory")
#define PG8_WAIT_L(n) asm volatile("s_waitcnt lgkmcnt(" #n ")" ::: "memory")
#define PG8_BAR __builtin_amdgcn_s_barrier()
#define PG8_SCHED __builtin_amdgcn_sched_barrier(0)
    Unit cur, nxt; int ui = 0;
    if (!S.next(0, cur)) return;
    f32x4 acc[2][2][4][2];
#pragma unroll
    for (int a = 0; a < 2; ++a)
#pragma unroll
        for (int b = 0; b < 2; ++b)
#pragma unroll
            for (int m = 0; m < 4; ++m)
#pragma unroll
                for (int n = 0; n < 2; ++n) acc[a][b][m][n] = (f32x4){0.f, 0.f, 0.f, 0.f};
    bf16x8 At[4][2], B0[2][2], B1[2][2];
    const char* cA = (const char*)g.A + (size_t)cur.pm * tstep; const char* cB = (const char*)g.Bt + (size_t)cur.pn * tstep;
    S.a_ready(cur);
    if constexpr (SP2) {
        PG8_STAGE(PG8_SB(0, 0), cB, voffB); PG8_STAGE(PG8_SB(0, 1), cB + hstep, voffB); PG8_STAGE(PG8_SA(0, 0), cA, voffA); PG8_STAGE(PG8_SA(0, 1), cA + hstep, voffA);
        if (wr == 1) PG8_BAR;
        PG8_WAIT_V(2); PG8_BAR;
        PG8_STAGE(PG8_SB(1, 0), cB + kstep, voffB); PG8_STAGE(PG8_SA(1, 0), cA + kstep, voffA); PG8_STAGE(PG8_SB(1, 1), cB + hstep + kstep, voffB);
        PG8_WAIT_V(6); PG8_BAR;
    } else {
        PG8_STAGE(PG8_SB(0, 0), cB, voffB); PG8_STAGE(PG8_SA(0, 0), cA, voffA); PG8_STAGE(PG8_SB(0, 1), cB + hstep, voffB); PG8_STAGE(PG8_SA(0, 1), cA + hstep, voffA);
        if (wr == 1) PG8_BAR;
        PG8_WAIT_V(4); PG8_BAR;
        PG8_STAGE(PG8_SB(1, 0), cB + kstep, voffB); PG8_STAGE(PG8_SA(1, 0), cA + kstep, voffA); PG8_STAGE(PG8_SB(1, 1), cB + hstep + kstep, voffB);
        PG8_WAIT_V(6); PG8_BAR;
    }
    for (;;) {
        const bool has_next = S.next(ui + 1, nxt);
        const char* nA = has_next ? (const char*)g.A + (size_t)nxt.pm * tstep : cA; const char* nB = has_next ? (const char*)g.Bt + (size_t)nxt.pn * tstep : cB;
        for (int t = 0; t < nt; t += 2) {
            const bool last = (t == nt - 2);
            const char* a1 = cA + (size_t)(t + 1) * kstep;
            const char* a2 = last ? nA : cA + (size_t)(t + 2) * kstep; const char* b2 = last ? nB : cB + (size_t)(t + 2) * kstep;
            const char* a3 = a2 + kstep; const char* b3 = b2 + kstep;
            if (last && has_next) S.a_ready(nxt);
            if constexpr (SP2) {
            PG8_LDB(B0, 0, 0); PG8_LDB(B1, 0, 1); PG8_SCHED; PG8_LDA(At, 0, 0); PG8_STAGE(PG8_SA(1, 1), a1 + hstep, voffA);
            PG8_WAIT_V(8); PG8_WAIT_L(0); PG8_BAR; PG8_MMA(0, 0, At, B0); PG8_MMA(0, 1, At, B1); PG8_BAR; PG8_SCHED;
            PG8_LDA(At, 0, 1); PG8_STAGE(PG8_SB(0, 0), b2, voffB); PG8_STAGE(PG8_SB(0, 1), b2 + hstep, voffB); PG8_STAGE(PG8_SA(0, 0), a2, voffA);
            PG8_WAIT_V(8); PG8_WAIT_L(0); PG8_BAR; PG8_MMA(1, 0, At, B0); PG8_MMA(1, 1, At, B1); PG8_BAR; PG8_SCHED;
            PG8_LDB(B0, 1, 0); PG8_LDB(B1, 1, 1); PG8_SCHED; PG8_LDA(At, 1, 0); PG8_STAGE(PG8_SA(0, 1), a2 + hstep, voffA);
            PG8_WAIT_V(8); PG8_WAIT_L(0); PG8_BAR; PG8_MMA(0, 0, At, B0); PG8_MMA(0, 1, At, B1); PG8_BAR; PG8_SCHED;
            PG8_LDA(At, 1, 1); PG8_STAGE(PG8_SB(1, 0), b3, voffB); PG8_STAGE(PG8_SB(1, 1), b3 + hstep, voffB); PG8_STAGE(PG8_SA(1, 0), a3, voffA);
            PG8_WAIT_V(8); PG8_WAIT_L(0); PG8_BAR; PG8_MMA(1, 0, At, B0); PG8_MMA(1, 1, At, B1); PG8_BAR; PG8_SCHED;
            } else {
            PG8_LDB(B0, 0, 0); PG8_SCHED; PG8_LDA(At, 0, 0); PG8_STAGE(PG8_SA(1, 1), a1 + hstep, voffA);
            PG8_WAIT_L(8); PG8_BAR; PG8_WAIT_L(0); PG8_MMA(0, 0, At, B0); PG8_BAR; PG8_SCHED;
            PG8_LDB(B1, 0, 1); PG8_STAGE(PG8_SB(0, 0), b2, voffB);
            PG8_BAR; PG8_WAIT_L(0); PG8_MMA(0, 1, At, B1); PG8_BAR;
            PG8_LDA(At, 0, 1); PG8_STAGE(PG8_SA(0, 0), a2, voffA);
            PG8_BAR; PG8_WAIT_L(0); PG8_MMA(1, 0, At, B0); PG8_BAR; PG8_SCHED;
            PG8_STAGE(PG8_SB(0, 1), b2 + hstep, voffB);
            PG8_WAIT_V(6); PG8_BAR; PG8_MMA(1, 1, At, B1); PG8_BAR;
            PG8_LDB(B0, 1, 0); PG8_SCHED; PG8_LDA(At, 1, 0); PG8_STAGE(PG8_SA(0, 1), a2 + hstep, voffA);
            PG8_WAIT_L(8); PG8_BAR; PG8_WAIT_L(0); PG8_MMA(0, 0, At, B0); PG8_BAR; PG8_SCHED;
            PG8_LDB(B1, 1, 1); PG8_STAGE(PG8_SB(1, 0), b3, voffB);
            PG8_BAR; PG8_WAIT_L(0); PG8_MMA(0, 1, At, B1); PG8_BAR;
            PG8_LDA(At, 1, 1); PG8_STAGE(PG8_SA(1, 0), a3, voffA);
            PG8_BAR; PG8_WAIT_L(0); PG8_MMA(1, 0, At, B0); PG8_BAR; PG8_SCHED;
            PG8_STAGE(PG8_SB(1, 1), b3 + hstep, voffB);
            PG8_WAIT_V(6); PG8_BAR; PG8_MMA(1, 1, At, B1); PG8_BAR;
            }
        }
        if constexpr (ALIGN_EPI) { if (wr == 0) PG8_BAR; }
        if constexpr (!Epi::AFTER_DRAIN) { E(acc, cur, wr, wc, fr, fq); S.done(cur); }
        if (!has_next) break;
#pragma unroll
        for (int a = 0; a < 2; ++a)
#pragma unroll
            for (int b = 0; b < 2; ++b)
#pragma unroll
                for (int m = 0; m < 4; ++m)
#pragma unroll
                    for (int n = 0; n < 2; ++n) acc[a][b][m][n] = (f32x4){0.f, 0.f, 0.f, 0.f};
        cur = nxt; cA = nA; cB = nB; ++ui;
        if constexpr (ALIGN_EPI) { if (wr == 1) PG8_BAR; }
    }
    PG8_WAIT_V(0);
    if constexpr (!ALIGN_EPI) { if (wr == 0) PG8_BAR; }
    PG8_BAR;
    if constexpr (Epi::AFTER_DRAIN) { E.fused(acc, cur, wr, wc, fr, fq, lds, wid, lane); S.done(cur); }
#undef PG8_SA
#undef PG8_SB
#undef PG8_STAGE
#undef PG8_LDA
#undef PG8_LDB
#undef PG8_MMA
#undef PG8_WAIT_V
#undef PG8_WAIT_L
#undef PG8_BAR
#undef PG8_SCHED
}
}
#define GAS __attribute__((address_space(1)))
#define LAS __attribute__((address_space(3)))
typedef unsigned short bf16;
typedef unsigned v4u __attribute__((ext_vector_type(4)));
typedef float f32x4 __attribute__((ext_vector_type(4)));
typedef short bf16x8 __attribute__((ext_vector_type(8)));
typedef GAS unsigned gu32;
typedef GAS unsigned long long gu64;
#define RLX_AGENT __ATOMIC_RELAXED, __HIP_MEMORY_SCOPE_AGENT
#define LDS_WAIT() asm volatile("s_waitcnt lgkmcnt(0)" ::: "memory")
#define VM_WAIT() asm volatile("s_waitcnt vmcnt(0)" ::: "memory")
__device__ __forceinline__ unsigned long long rt() { return __builtin_amdgcn_s_memrealtime(); }
__device__ __forceinline__ unsigned f2bf(float f) { unsigned u = __builtin_bit_cast(unsigned, f); return (u + 0x7fffu + ((u >> 16) & 1u)) >> 16; }
__device__ __forceinline__ unsigned pk2(float lo, float hi) { return f2bf(lo) | (f2bf(hi) << 16); }
#define XB_TMO      128
#define XB_XCNT(j)  (256  + 64 * (j))
#define XB_XSUB(j)  (1280 + 64 * (j))
#define XB_XGEN(j)  (2304 + 64 * (j))
#define XB_TOP      3328
#define XB_TOPGEN   3392
#define XCD_BAR_WORDS 3456
#define XB_SPIN_CAP (1u << 18)

__device__ __forceinline__ unsigned xb_ld(unsigned* p)              { return __hip_atomic_load(p, __ATOMIC_RELAXED, __HIP_MEMORY_SCOPE_AGENT); }
__device__ __forceinline__ unsigned xb_add(unsigned* p, unsigned v) { return __hip_atomic_fetch_add(p, v, __ATOMIC_RELAXED, __HIP_MEMORY_SCOPE_AGENT); }
__device__ __forceinline__ unsigned xb_xcc_id() { return (unsigned)__builtin_amdgcn_s_getreg((3 << 11) | 20) & 0xFu; }
#define XB_SPIN(cond, bar) do { unsigned _sp = 0; while (cond) { __builtin_amdgcn_s_sleep(1); \
    if ((++_sp & 255u) == 0u) { if (xb_ld(&(bar)[XB_TMO])) break; if (_sp > XB_SPIN_CAP) { atomicAdd(&(bar)[XB_TMO], 1u); break; } } } } while (0)

struct XcdBarrier {
    unsigned* bar; unsigned x;
    volatile LAS unsigned* st;
};

__device__ __forceinline__ XcdBarrier xcd_barrier_post(unsigned* bar, volatile LAS unsigned* st) {
    XcdBarrier b; b.bar = bar; b.x = xb_xcc_id(); b.st = st;
    if (threadIdx.x == 0) (void)xb_add(&bar[XB_XCNT(b.x)], 1u);
    return b;
}
__device__ __forceinline__ void xcd_barrier_complete(unsigned* bar, unsigned x, unsigned& nloc, unsigned& nx) {
    const unsigned G = gridDim.x * gridDim.y * gridDim.z;
    unsigned sum, cnt, mine, sp = 0u;
    for (;;) {
        sum = 0u; cnt = 0u; mine = 0u;
#pragma unroll
        for (unsigned j = 0; j < 16; ++j) { const unsigned c = xb_ld(&bar[XB_XCNT(j)]); sum += c; cnt += (c > 0u) ? 1u : 0u; mine = (j == x) ? c : mine; }
        if (sum == G) break;
        __builtin_amdgcn_s_sleep(1);
        if ((++sp & 255u) == 0u) { if (xb_ld(&bar[XB_TMO])) break; if (sp > XB_SPIN_CAP) { atomicAdd(&bar[XB_TMO], 1u); break; } }
    }
    nloc = mine > 0u ? mine : 1u; nx = cnt > 0u ? cnt : 1u;
}

__device__ __forceinline__ void xcd_barrier(const XcdBarrier& b) {
    asm volatile("s_waitcnt vmcnt(0)" ::: "memory");
    __syncthreads();
    if (threadIdx.x == 0) {
        unsigned* bar = b.bar;
        __builtin_amdgcn_s_waitcnt(0);
        unsigned nloc = b.st[0], nx = b.st[1];
        if (nloc == 0u) { xcd_barrier_complete(bar, b.x, nloc, nx); b.st[0] = nloc; b.st[1] = nx; }
        const unsigned old = xb_add(&bar[XB_XSUB(b.x)], 1u);
        const unsigned gen = old / nloc;
        if (old + 1u == (gen + 1u) * nloc) {
            __builtin_amdgcn_fence(__ATOMIC_RELEASE, "agent");
            asm volatile("s_waitcnt vmcnt(0)" ::: "memory");
            const unsigned og = xb_add(&bar[XB_TOP], 1u);
            const unsigned tg = og / nx;
            if (og + 1u == (tg + 1u) * nx) xb_add(&bar[XB_TOPGEN], 1u);
            else XB_SPIN(xb_ld(&bar[XB_TOPGEN]) == tg, bar);
            __builtin_amdgcn_fence(__ATOMIC_ACQUIRE, "agent");
            xb_add(&bar[XB_XGEN(b.x)], 1u);
            asm volatile("s_waitcnt vmcnt(0)" ::: "memory");
        } else {
            XB_SPIN(xb_ld(&bar[XB_XGEN(b.x)]) == gen, bar);
            __builtin_amdgcn_fence(__ATOMIC_ACQUIRE, "agent");
            asm volatile("s_waitcnt vmcnt(0)" ::: "memory");
        }
    }
    __syncthreads();
}

constexpr int NWAVES = 8, NTHR = NWAVES * 64;
constexpr int BATCH = 2, SEQ = 16384, D = 1024, FF = 2816, M = BATCH * SEQ;
constexpr int NCHUNK = M / 128;
constexpr float EPS = 1e-6f;
constexpr size_t MiB = 1u << 20;
constexpr size_t WS_CTL = 0, CTL_ZERO_BYTES = 1 * MiB;
constexpr size_t WS_W = 1 * MiB;
constexpr size_t W13_BYTES = (size_t)2 * FF * D * 2, W2_BYTES = (size_t)D * FF * 2, WIN_BYTES = (size_t)2048 * D * 2, WOUT_BYTES = (size_t)D * D * 2;
constexpr size_t LW_W13 = 0, LW_W2 = 2 * W13_BYTES, LW_WIN = LW_W2 + 2 * W2_BYTES, LW_WOUT = LW_WIN + WIN_BYTES, LAYER_W_BYTES = LW_WOUT + WOUT_BYTES;
static_assert(LAYER_W_BYTES == 39 * MiB, "weights");
constexpr size_t WS_XN = 80 * MiB;
constexpr size_t WS_ACT = 144 * MiB;
constexpr size_t WS_PC = WS_ACT + 128 * MiB;
constexpr size_t WS_Y = 320 * MiB;
constexpr size_t WS_MISC = 384 * MiB;
constexpr size_t WS_ST0 = WS_MISC, WS_ST1 = WS_MISC + 2 * MiB, WS_ST2 = WS_MISC + 4 * MiB;
constexpr size_t WS_MODP = WS_MISC + 6 * MiB;
constexpr size_t WS_PAR = WS_MISC + 11 * MiB;
constexpr size_t WS_WSB = WS_MISC + 12 * MiB;
constexpr size_t WS_GWT = WS_MISC + 12 * MiB + 512 * 1024;
constexpr size_t WS_SUMM = WS_MISC + 13 * MiB;
constexpr size_t WS_XB = WS_MISC + 16 * MiB;
constexpr size_t WS_END = WS_XB + 64 * MiB;
static_assert(WS_W + 2 * LAYER_W_BYTES <= WS_XN && WS_PC + (size_t)M * 512 * 2 <= WS_Y, "d_ws map");
constexpr int CW_BAR = 4096, CW_XRANK = 32768, CW_LBAR = 40960, CW_M1PUB = 53248, CW_M1DONE = 53312;
constexpr int RING_BYTES = 131072, LDS_BYTES = 147456, LDSCTL_OFF = LDS_BYTES - 512, MISC_OFF = LDSCTL_OFF;

struct Args { const float* in[26]; float* out; unsigned char* ws; };
enum { I_X = 0, I_C, I_ADAW, I_ADAB, I_NPRE, I_NPOST, I_W13, I_W2, I_ABWIN, I_ACW, I_ACB, I_AGW, I_AGB, I_ALAM, I_BCW, I_BCB, I_BNG, I_BNB, I_ABWOUT, I_CWIN, I_CBIN, I_CNG, I_CNB, I_CWS, I_CBS, I_CWOUT };

__device__ __forceinline__ float dpp_row_shr(float v, int n) {
    const int iv = __builtin_bit_cast(int, v); int r;
    switch (n) { case 1: r = __builtin_amdgcn_update_dpp(0, iv, 0x111, 0xf, 0xf, true); break; case 2: r = __builtin_amdgcn_update_dpp(0, iv, 0x112, 0xf, 0xf, true); break;
                 case 4: r = __builtin_amdgcn_update_dpp(0, iv, 0x114, 0xf, 0xf, true); break; default: r = __builtin_amdgcn_update_dpp(0, iv, 0x118, 0xf, 0xf, true); break; }
    return __builtin_bit_cast(float, r);
}
__device__ __forceinline__ float row16_sum(float v) {
    v += dpp_row_shr(v, 1); v += dpp_row_shr(v, 2); v += dpp_row_shr(v, 4); v += dpp_row_shr(v, 8);
    return __builtin_bit_cast(float, __builtin_amdgcn_readlane(__builtin_bit_cast(int, v), 15));
}
__device__ __forceinline__ float wave_sum(float v) {
    v += dpp_row_shr(v, 1); v += dpp_row_shr(v, 2); v += dpp_row_shr(v, 4); v += dpp_row_shr(v, 8);
    v += __builtin_bit_cast(float, __builtin_amdgcn_update_dpp(0, __builtin_bit_cast(int, v), 0x142, 0xa, 0xf, false));
    v += __builtin_bit_cast(float, __builtin_amdgcn_update_dpp(0, __builtin_bit_cast(int, v), 0x143, 0xc, 0xf, false));
    return __builtin_bit_cast(float, __builtin_amdgcn_readlane(__builtin_bit_cast(int, v), 63));
}
__device__ __forceinline__ float neg_expm1(float x) {
    const float p = x * (1.0f + x * (0.5f + x * (0.16666667f + x * (0.041666668f + x * (0.0083333338f + x * 0.0013888889f)))));
    return (x > -0.25f) ? -p : 1.0f - __expf(x);
}
__device__ __forceinline__ float bf2f(unsigned h) { return __uint_as_float(h << 16); }
__device__ __forceinline__ float bflo(unsigned w) { return __uint_as_float(w << 16); }
__device__ __forceinline__ float bfhi(unsigned w) { return __uint_as_float(w & 0xffff0000u); }
__device__ __forceinline__ float fsig(float x) { return __builtin_amdgcn_rcpf(1.0f + __expf(-x)); }
__device__ __forceinline__ float gelu_t(float x) { const float u = 1.5957691216f * (x + 0.044715f * x * x * x); return x * fsig(u); }
typedef unsigned u32x2 __attribute__((ext_vector_type(2)));

struct TItem { const float* src; bf16* dst; int K, N; };
__device__ __forceinline__ TItem p0_decode(const Args& args, unsigned char* ws, int it) {
    constexpr int I13 = (D / 64) * (2 * FF / 32), I2 = (FF / 64) * (D / 32), IWIN = (D / 64) * (2048 / 32), IWOUT = (D / 64) * (D / 32);
    const float* W; bf16* WT; int K, N, mode = 0; int r = it;
    if (r < 4 * I13) { const int mi = r / I13; r -= mi * I13; W = args.in[I_W13] + (size_t)mi * D * 2 * FF; K = D; N = 2 * FF; mode = 1; WT = (bf16*)(ws + WS_W + (size_t)(mi >> 1) * LAYER_W_BYTES + LW_W13 + (size_t)(mi & 1) * W13_BYTES); }
    else { r -= 4 * I13;
        if (r < 4 * I2) { const int mi = r / I2; r -= mi * I2; W = args.in[I_W2] + (size_t)mi * FF * D; K = FF; N = D; WT = (bf16*)(ws + WS_W + (size_t)(mi >> 1) * LAYER_W_BYTES + LW_W2 + (size_t)(mi & 1) * W2_BYTES); }
        else { r -= 4 * I2;
            if (r < IWIN) { W = args.in[I_ABWIN]; K = D; N = 2048; WT = (bf16*)(ws + WS_W + LW_WIN); }
            else { r -= IWIN;
                if (r < IWIN) { W = args.in[I_CWIN]; K = D; N = 2048; WT = (bf16*)(ws + WS_W + LAYER_W_BYTES + LW_WIN); }
                else { r -= IWIN;
                    if (r < IWOUT) { W = args.in[I_ABWOUT]; K = D; N = D; WT = (bf16*)(ws + WS_W + LW_WOUT); }
                    else { r -= IWOUT; W = args.in[I_CWOUT]; K = D; N = D; WT = (bf16*)(ws + WS_W + LAYER_W_BYTES + LW_WOUT); } } } } }
    const int nblk = N / 32, kb = r / nblk, nb = r % nblk, k0 = 64 * kb, n0 = 32 * nb;
    int rowbase = n0;
    if (mode == 1) { if (n0 < FF) rowbase = 256 * (n0 >> 7) + (n0 & 127); else { const int c = n0 - FF; rowbase = 256 * (c >> 7) + 128 + (c & 127); } }
    TItem t; t.src = W + (size_t)k0 * N + n0; t.dst = WT + (size_t)rowbase * K + k0; t.K = K; t.N = N; return t;
}
__device__ __forceinline__ void p0_item_load(const TItem& t, int lane, float (&v)[32]) {
#pragma unroll
    for (int i = 0; i < 32; ++i) v[i] = __builtin_nontemporal_load(t.src + (size_t)(2 * i + (lane >> 5)) * t.N + (lane & 31));
}
__device__ __forceinline__ void p0_item_store(const TItem& t, int lane, const float (&v)[32], LAS float* scr) {
#pragma unroll
    for (int i = 0; i < 32; ++i) scr[(2 * i + (lane >> 5)) * 33 + (lane & 31)] = v[i];
    LDS_WAIT(); asm volatile("" ::: "memory");
    const int c = lane & 7;
#pragma unroll
    for (int j = 0; j < 4; ++j) { const int n = (lane >> 3) + 8 * j; const LAS float* s = scr + (8 * c) * 33 + n;
        v4u o; o.x = pk2(s[0 * 33], s[1 * 33]); o.y = pk2(s[2 * 33], s[3 * 33]); o.z = pk2(s[4 * 33], s[5 * 33]); o.w = pk2(s[6 * 33], s[7 * 33]);
        *(GAS v4u*)(t.dst + (size_t)n * t.K + 8 * c) = o; }
    LDS_WAIT(); asm volatile("" ::: "memory");
}

template <bool RES, bool NORM, int XIN, int XOUT>
__device__ __forceinline__ void trans_phase(int gw, int NGW, int lane_, const void* xin_, void* xout_, const bf16* Y, const float* st,
                                            const float* A1p, const float* A2p, const float* A3p, bf16* XN) {
    int lane = lane_; asm volatile("" : "+v"(lane));
    for (int blk = gw; blk < M / 16; blk += NGW) {
        const int rbase = blk * 16, b = rbase / SEQ;
        f32x4 A1[4], A2[4], A3[4];
#pragma unroll
        for (int j = 0; j < 4; ++j) {
            if (RES) A1[j] = *(const f32x4*)(A1p + b * 3072 + 4 * lane + 256 * j);
            if (NORM) { A2[j] = *(const f32x4*)(A2p + b * 3072 + 4 * lane + 256 * j); A3[j] = *(const f32x4*)(A3p + b * 3072 + 4 * lane + 256 * j); }
        }
#pragma unroll 1
        for (int r4 = 0; r4 < 16; r4 += 4) {
            f32x4 xv[4][4]; u32x2 xb[4][4]; u32x2 yv[4][4]; float sp[4];
#pragma unroll
            for (int r = 0; r < 4; ++r) { const size_t row = (size_t)(rbase + r4 + r);
#pragma unroll
                for (int j = 0; j < 4; ++j) { if (XIN == 0) xv[r][j] = __builtin_nontemporal_load((const f32x4*)((const float*)xin_ + row * D + 4 * lane + 256 * j)); else xb[r][j] = __builtin_nontemporal_load((const u32x2*)((const bf16*)xin_ + row * D + 4 * lane + 256 * j)); }
                if (RES) {
#pragma unroll
                    for (int j = 0; j < 4; ++j) yv[r][j] = __builtin_nontemporal_load((const u32x2*)(Y + row * D + 4 * lane + 256 * j));
                    sp[r] = st[row * 16 + (lane & 15)]; } }
#pragma unroll
            for (int r = 0; r < 4; ++r) { const size_t row = (size_t)(rbase + r4 + r);
                if (XIN == 1) {
#pragma unroll
                    for (int j = 0; j < 4; ++j) xv[r][j] = (f32x4){bflo(xb[r][j].x), bfhi(xb[r][j].x), bflo(xb[r][j].y), bfhi(xb[r][j].y)}; }
                if (RES) {
                    const float ss = row16_sum(sp[r]);
                    const float rstd = rsqrtf(ss * (1.0f / D) + EPS);
#pragma unroll
                    for (int j = 0; j < 4; ++j) { const f32x4 y = (f32x4){bflo(yv[r][j].x), bfhi(yv[r][j].x), bflo(yv[r][j].y), bfhi(yv[r][j].y)};
                        xv[r][j] = xv[r][j] + A1[j] * y * rstd; }
                }
                if (XOUT == 2) {
#pragma unroll
                    for (int j = 0; j < 4; ++j) __builtin_nontemporal_store(xv[r][j], (f32x4*)((float*)xout_ + row * D + 4 * lane + 256 * j)); }
                if (XOUT == 1) {
#pragma unroll
                    for (int j = 0; j < 4; ++j) { u32x2 w; w.x = pg8::cvt_pk_bf16(xv[r][j].x, xv[r][j].y); w.y = pg8::cvt_pk_bf16(xv[r][j].z, xv[r][j].w);
                        __builtin_nontemporal_store(w, (u32x2*)((bf16*)xout_ + row * D + 4 * lane + 256 * j)); } }
                if (NORM) {
                    float q = 0.f;
#pragma unroll
                    for (int j = 0; j < 4; ++j) q += (xv[r][j].x * xv[r][j].x + xv[r][j].y * xv[r][j].y) + (xv[r][j].z * xv[r][j].z + xv[r][j].w * xv[r][j].w);
                    q = wave_sum(q);
                    const float r2 = rsqrtf(q * (1.0f / D) + EPS);
#pragma unroll
                    for (int j = 0; j < 4; ++j) { const f32x4 h = xv[r][j] * r2 * A2[j] + A3[j];
                        u32x2 w; w.x = pg8::cvt_pk_bf16(h.x, h.y); w.y = pg8::cvt_pk_bf16(h.z, h.w);
                        *(u32x2*)(XN + row * D + 4 * lane + 256 * j) = w; }
                }
            }
        }
    }
}

template <int PASS>
__device__ __forceinline__ void m1_partA(const Args& a, unsigned char* ws, LAS unsigned char* lds, int ci, int w, int lane_) {
    int lane = lane_; asm volatile("" : "+v"(lane));
    const bf16* Z = (const bf16*)(ws + WS_ACT); float* SUMM = (float*)(ws + WS_SUMM); bf16* YCAT = (bf16*)(ws + WS_XN);
    const int ch = w * 64 + lane, row0 = ci * 128; const bool first = (ci % (SEQ / 128)) == 0;
    LAS bf16* xcl = (LAS bf16*)(lds + w * 10752);
    LAS float* gl = (LAS float*)(lds + w * 10752 + 2304);
    const int fr = lane & 15, fq = lane >> 4;
    const bf16* GWT = (const bf16*)(ws + WS_GWT);
    bf16x8 gB[8][2];
#pragma unroll
    for (int et = 0; et < 8; ++et)
#pragma unroll
        for (int ks = 0; ks < 2; ++ks) gB[et][ks] = *(const bf16x8*)(GWT + ((size_t)w * 128 + et * 16 + fr) * 64 + ks * 32 + 8 * fq);
    const float* cwp = a.in[I_ACW];
    const float cw0 = cwp[ch], cw1 = cwp[512 + ch], cw2 = cwp[1024 + ch], cw3 = cwp[1536 + ch], cb = a.in[I_ACB][ch];
    const float lam = a.in[I_ALAM][ch];
    const float c8 = -8.0f * log1pf(expf(-lam));
    const bool small_all = __builtin_amdgcn_ballot_w64(c8 > -0.25f) == ~0ull;
    const float gbr = a.in[I_AGB][w * 128 + lane], gbi = a.in[I_AGB][w * 128 + 64 + lane];
    const bf16* zx = Z + 512 + ch; const bf16* zg = Z + ch;
    float xm3 = 0.f, xm2 = 0.f, xm1 = 0.f;
    if (!first) { xm3 = bf2f(zx[(size_t)(row0 - 3) * 2048]); xm2 = bf2f(zx[(size_t)(row0 - 2) * 2048]); xm1 = bf2f(zx[(size_t)(row0 - 1) * 2048]); }
    float hl = 0.f, P = 1.f;
    if (PASS == 1) { const int c0 = (ci / (SEQ / 128)) * (SEQ / 128);
#pragma unroll 32
        for (int c = c0; c < ci; ++c) { const pg8::f32x2 sm = *(const pg8::f32x2*)(SUMM + ((size_t)c * 512 + ch) * 2); hl = sm.x * hl + sm.y; } }
    unsigned short nx[16], ng[16];
#pragma unroll
    for (int i = 0; i < 16; ++i) { nx[i] = zx[(size_t)(row0 + i) * 2048]; if (PASS == 1) ng[i] = zg[(size_t)(row0 + i) * 2048]; }
#pragma unroll 1
    for (int sc = 0; sc < 8; ++sc) {
        float xc[16]; float ag[16];
#pragma unroll
        for (int i = 0; i < 16; ++i) { const float x = bf2f(nx[i]); xc[i] = cb + cw0 * xm3 + cw1 * xm2 + cw2 * xm1 + cw3 * x; xm3 = xm2; xm2 = xm1; xm1 = x;
            if (PASS == 1) ag[i] = bf2f(ng[i]);
            xcl[i * 72 + lane] = (bf16)f2bf(xc[i]); }
        if (sc < 7) {
#pragma unroll
            for (int i = 0; i < 16; ++i) { nx[i] = zx[(size_t)(row0 + 16 * (sc + 1) + i) * 2048]; if (PASS == 1) ng[i] = zg[(size_t)(row0 + 16 * (sc + 1) + i) * 2048]; } }
        LDS_WAIT(); asm volatile("" ::: "memory");
        f32x4 acc[8];
#pragma unroll
        for (int et = 0; et < 8; ++et) acc[et] = (f32x4){0.f, 0.f, 0.f, 0.f};
#pragma unroll
        for (int ks = 0; ks < 2; ++ks) { const bf16x8 af = *(const LAS bf16x8*)(xcl + fr * 72 + ks * 32 + 8 * fq);
#pragma unroll
            for (int et = 0; et < 8; ++et) acc[et] = __builtin_amdgcn_mfma_f32_16x16x32_bf16(af, gB[et][ks], acc[et], 0, 0, 0); }
#pragma unroll
        for (int et = 0; et < 8; ++et)
#pragma unroll
            for (int r = 0; r < 4; ++r) gl[(4 * fq + r) * 132 + et * 16 + fr] = acc[et][r];
        LDS_WAIT(); asm volatile("" ::: "memory");
#pragma unroll
        for (int i = 0; i < 16; i += 2) {
            typedef pg8::f32x2 v2;
            const v2 gr = (v2){gl[i * 132 + lane], gl[(i + 1) * 132 + lane]} + gbr, gi = (v2){gl[i * 132 + 64 + lane], gl[(i + 1) * 132 + 64 + lane]} + gbi;
            const v2 tr = gr * (-1.4426950408889634f), ti = gi * (-1.4426950408889634f);
            v2 dr, di; dr.x = __builtin_amdgcn_exp2f(tr.x); dr.y = __builtin_amdgcn_exp2f(tr.y); di.x = __builtin_amdgcn_exp2f(ti.x); di.y = __builtin_amdgcn_exp2f(ti.y);
            dr = dr + 1.0f; di = di + 1.0f;
            v2 r, ig; r.x = __builtin_amdgcn_rcpf(dr.x); r.y = __builtin_amdgcn_rcpf(dr.y); ig.x = __builtin_amdgcn_rcpf(di.x); ig.y = __builtin_amdgcn_rcpf(di.y);
            const v2 la = r * c8;
            v2 em;
            if (small_all) { v2 q = la * 0.0013888889f + 0.0083333338f; q = q * la + 0.041666668f; q = q * la + 0.16666667f; q = q * la + 0.5f; q = q * la + 1.0f; em = q * la; }
            else { em.x = __expf(la.x) - 1.0f; em.y = __expf(la.y) - 1.0f; }
            const v2 av = em + 1.0f, m2 = -em * (em + 2.0f);
            v2 mult; mult.x = __builtin_amdgcn_sqrtf(m2.x); mult.y = __builtin_amdgcn_sqrtf(m2.y);
            const v2 uu = mult * ig * (v2){xc[i], xc[i + 1]};
            const float h0 = av.x * hl + uu.x, h1 = av.y * h0 + uu.y; hl = h1;
            if (PASS == 0) P *= av.x * av.y;
            else { const v2 g = (v2){ag[i], ag[i + 1]};
                const v2 tg = (g * g * 0.044715f + 1.0f) * g * (-1.5957691216f * 1.4426950408889634f);
                v2 dg; dg.x = __builtin_amdgcn_exp2f(tg.x); dg.y = __builtin_amdgcn_exp2f(tg.y); dg = dg + 1.0f;
                v2 rg; rg.x = __builtin_amdgcn_rcpf(dg.x); rg.y = __builtin_amdgcn_rcpf(dg.y);
                const v2 y = (v2){h0, h1} * g * rg;
                YCAT[(size_t)(row0 + 16 * sc + i) * 1024 + ch] = (bf16)f2bf(y.x); YCAT[(size_t)(row0 + 16 * sc + i + 1) * 1024 + ch] = (bf16)f2bf(y.y); }
        }
        LDS_WAIT(); asm volatile("" ::: "memory");
    }
    if (PASS == 0)
        __hip_atomic_store((unsigned long long*)(SUMM + ((size_t)ci * 512 + ch) * 2), ((unsigned long long)__float_as_uint(hl) << 32) | (unsigned long long)__float_as_uint(P), __ATOMIC_RELAXED, __HIP_MEMORY_SCOPE_AGENT);
}

__device__ __forceinline__ void m1_partB(const Args& a, unsigned char* ws, int ci, int w, int lane_) {
    int lane = lane_; asm volatile("" : "+v"(lane));
    const bf16* Z = (const bf16*)(ws + WS_ACT); bf16* YCAT = (bf16*)(ws + WS_XN);
    const int ch = w * 64 + lane, row0 = ci * 128; const bool first = (ci % (SEQ / 128)) == 0;
    {
        float bw[31];
#pragma unroll
        for (int k = 0; k < 31; ++k) bw[k] = a.in[I_BCW][k * 512 + ch];
        const float bb = a.in[I_BCB][ch], ng = a.in[I_BNG][ch], nb = a.in[I_BNB][ch];
        const bf16* zv = Z + 1024 + ch; const bf16* zg = Z + 1536 + ch;
        float win[32];
        win[0] = 0.f; win[1] = 0.f;
#pragma unroll
        for (int j = 2; j < 32; ++j) { float v = 0.f; if (!first) { const size_t row = (size_t)(row0 - 32 + j); v = bf2f(zv[row * 2048]) * fsig(bf2f(zg[row * 2048])); } win[j] = v; }
#pragma unroll 1
        for (int base = 0; base < 128; base += 32) {
            unsigned rvg[32];
#pragma unroll
            for (int j = 0; j < 32; ++j) { const size_t row = (size_t)(row0 + base + j); rvg[j] = (unsigned)zv[row * 2048] | ((unsigned)zg[row * 2048] << 16); }
#pragma unroll
            for (int j4 = 0; j4 < 32; j4 += 4) {
                float ac[4], dl[4], vr[4];
#pragma unroll
                for (int q = 0; q < 4; ++q) { const int j = j4 + q; win[j] = bflo(rvg[j]) * fsig(bfhi(rvg[j]));
                    float acc = bb;
#pragma unroll
                    for (int k = 0; k < 31; ++k) acc += bw[k] * win[(j + 2 + k) & 31];
                    ac[q] = acc; }
#pragma unroll
                for (int q = 0; q < 4; ++q) dl[q] = ac[q] - wave_sum(ac[q]) * (1.0f / 64.0f);
#pragma unroll
                for (int q = 0; q < 4; ++q) vr[q] = wave_sum(dl[q] * dl[q]) * (1.0f / 64.0f);
#pragma unroll
                for (int q = 0; q < 4; ++q) { const float y = dl[q] * rsqrtf(vr[q] + EPS) * ng + nb;
                    YCAT[(size_t)(row0 + base + j4 + q) * 1024 + 512 + ch] = (bf16)f2bf(y * fsig(y)); }
            }
        }
    }
}

__device__ __forceinline__ void sg_chunk(const Args& a, unsigned char* ws, LAS unsigned char* lds, int ci, int w, int lane_, int tid_) {
    int lane = lane_, tid = tid_; asm volatile("" : "+v"(lane), "+v"(tid));
    const bf16* Z = (const bf16*)(ws + WS_ACT); bf16* UG = (bf16*)(ws + WS_XN); const bf16* WSB = (const bf16*)(ws + WS_WSB);
    const float* S1 = (const float*)(ws + WS_ST1); const float* S2 = (const float*)(ws + WS_ST2);
    LAS float* sm = (LAS float*)lds;
    LAS bf16* vT = (LAS bf16*)(lds + 1024 + w * 17408);
    const int row0 = ci * 128;
    if (tid < 128) { const size_t row = (size_t)(row0 + tid); float s1 = 0.f, s2 = 0.f;
#pragma unroll
        for (int i = 0; i < 4; ++i) { const f32x4 p = *(const f32x4*)(S1 + row * 16 + 4 * i), q = *(const f32x4*)(S2 + row * 16 + 4 * i); s1 += (p.x + p.y) + (p.z + p.w); s2 += (q.x + q.y) + (q.z + q.w); }
        const float mean = s1 * (1.0f / 1024.0f), var = s2 * (1.0f / 1024.0f) - mean * mean;
        sm[2 * tid] = mean; sm[2 * tid + 1] = rsqrtf(var + EPS); }
    __syncthreads();
    const int fr = lane & 15, fq = lane >> 4;
    bf16x8 yfr[8][4];
#pragma unroll
    for (int tt = 0; tt < 8; ++tt)
#pragma unroll
        for (int ks = 0; ks < 4; ++ks) if (ks < tt / 2 + 1) yfr[tt][ks] = *(const bf16x8*)(WSB + ((size_t)w * 128 + tt * 16 + fr) * 128 + ks * 32 + 8 * fq);
#pragma unroll 1
    for (int hh = 0; hh < 2; ++hh) {
        const int cbase = w * 128 + hh * 64;
        { const int csub = (lane & 7) * 8, sl = lane >> 3;
            float g8[8], b8[8];
#pragma unroll
            for (int e = 0; e < 8; ++e) { g8[e] = a.in[I_CNG][cbase + csub + e]; b8[e] = a.in[I_CNB][cbase + csub + e]; }
#pragma unroll 1
            for (int i0 = 0; i0 < 16; i0 += 8) {
                v4u raw[8];
#pragma unroll
                for (int i = 0; i < 8; ++i) raw[i] = *(const v4u*)(Z + (size_t)(row0 + sl + 8 * (i0 + i)) * 2048 + 1024 + cbase + csub);
#pragma unroll
                for (int i = 0; i < 8; ++i) { const int s = sl + 8 * (i0 + i);
                    const float mean = sm[2 * s], rstd = sm[2 * s + 1];
                    const unsigned rw[4] = {raw[i].x, raw[i].y, raw[i].z, raw[i].w};
#pragma unroll
                    for (int e = 0; e < 8; ++e) { const float v = (e & 1) ? bfhi(rw[e >> 1]) : bflo(rw[e >> 1]);
                        vT[(csub + e) * 136 + (s ^ csub)] = (bf16)f2bf((v - mean) * rstd * g8[e] + b8[e]); } }
            }
        }
        LDS_WAIT(); asm volatile("" ::: "memory");
#pragma unroll
        for (int tt = 0; tt < 8; ++tt) {
            const int t = tt * 16 + fr; const size_t row = (size_t)(row0 + t); const float bs = a.in[I_CBS][w * 128 + t];
            u32x2 uu[4];
#pragma unroll
            for (int ct = 0; ct < 4; ++ct) uu[ct] = *(const u32x2*)(Z + row * 2048 + cbase + ct * 16 + 4 * fq);
            f32x4 acc[4];
#pragma unroll
            for (int ct = 0; ct < 4; ++ct) acc[ct] = (f32x4){0.f, 0.f, 0.f, 0.f};
#pragma unroll
            for (int ks = 0; ks < tt / 2 + 1; ++ks) {
#pragma unroll
                for (int ct = 0; ct < 4; ++ct) { const bf16x8 xf = *(const LAS bf16x8*)(vT + (ct * 16 + fr) * 136 + ((ks * 32 + 8 * fq) ^ (((ct * 16 + fr) >> 3) << 3)));
                    acc[ct] = __builtin_amdgcn_mfma_f32_16x16x32_bf16(xf, yfr[tt][ks], acc[ct], 0, 0, 0); }
            }
#pragma unroll
            for (int ct = 0; ct < 4; ++ct) { const int cc = cbase + ct * 16 + 4 * fq;
                u32x2 o; o.x = pg8::cvt_pk_bf16(bflo(uu[ct].x) * (acc[ct][0] + bs), bfhi(uu[ct].x) * (acc[ct][1] + bs)); o.y = pg8::cvt_pk_bf16(bflo(uu[ct].y) * (acc[ct][2] + bs), bfhi(uu[ct].y) * (acc[ct][3] + bs));
                *(u32x2*)(UG + row * 1024 + cc) = o; }
        }
        LDS_WAIT(); asm volatile("" ::: "memory");
    }
    __syncthreads();
}

__global__ void __launch_bounds__(NTHR, 2) mega_fwd(Args args) {
    extern __shared__ __attribute__((aligned(16))) unsigned char lds_raw[];
    LAS unsigned char* lds = (LAS unsigned char*)lds_raw;
    volatile LAS unsigned* MISC = (volatile LAS unsigned*)(lds + MISC_OFF);
    const int tid = threadIdx.x, lane = tid & 63, wave = __builtin_amdgcn_readfirstlane(tid >> 6);
    const int G = gridDim.x, bx = blockIdx.x;
    const int gw = bx * NWAVES + wave, NGW = G * NWAVES;
    unsigned char* ws = args.ws;
    gu32* ctl = (gu32*)(ws + WS_CTL);
    for (int u = tid; u < (LDS_BYTES - LDSCTL_OFF) / 4; u += NTHR) ((LAS unsigned*)(lds + LDSCTL_OFF))[u] = 0u;
    __syncthreads();
    XcdBarrier bar = xcd_barrier_post((unsigned*)(ctl + CW_BAR), MISC + 8);
#define GRID_BAR() xcd_barrier(bar)
    if (tid == 0) MISC[16] = __hip_atomic_fetch_add((unsigned*)(ctl + CW_XRANK) + 64 * (bar.x & 7u), 1u, __ATOMIC_RELAXED, __HIP_MEMORY_SCOPE_AGENT);
    int cv = bx; bool loc_ok = false;
    unsigned* lb_cnt = (unsigned*)(ctl + CW_LBAR); unsigned* lb_gen = lb_cnt + 64;
#define LOC_BAR() do { if (loc_ok) { \
        asm volatile("s_waitcnt vmcnt(0)" ::: "memory"); __syncthreads(); \
        if (tid == 0) { __builtin_amdgcn_s_waitcnt(0); const unsigned old_ = xb_add(lb_cnt, 1u), g_ = old_ / 4u; \
            if (old_ + 1u == (g_ + 1u) * 4u) xb_add(lb_gen, 1u); \
            else { unsigned sp_ = 0u; while (xb_ld(lb_gen) == g_) { __builtin_amdgcn_s_sleep(1); if (++sp_ > (1u << 24)) break; } } \
            __builtin_amdgcn_fence(__ATOMIC_ACQUIRE, "agent"); asm volatile("s_waitcnt vmcnt(0)" ::: "memory"); } \
        __syncthreads(); } else xcd_barrier(bar); } while (0)

    float* PAR = (float*)(ws + WS_PAR);
    bf16* XB = (bf16*)(ws + WS_XB);
    bf16* XN = (bf16*)(ws + WS_XN); bf16* ACT = (bf16*)(ws + WS_ACT); bf16* YB = (bf16*)(ws + WS_Y);
    float* ST0 = (float*)(ws + WS_ST0); float* ST1 = (float*)(ws + WS_ST1); float* ST2 = (float*)(ws + WS_ST2);
#define PARP(l, s, q) (PAR + ((size_t)((l) * 3 + (s)) * 2) * 3072 + (q) * 1024)

    {
        { float* MODP = (float*)(ws + WS_MODP); const float* cp = args.in[I_C];
            for (int it = gw; it < 2 * 36 * 32; it += NGW) { const int l = it / 1152, rem = it % 1152, jb = rem / 32, kw = rem % 32;
                const float* wp = args.in[I_ADAW] + ((size_t)l * 1024 + kw * 32) * 9216 + jb * 256 + 4 * lane;
                f32x4 a0 = (f32x4){0.f, 0.f, 0.f, 0.f}, a1 = a0;
#pragma unroll 8
                for (int k = 0; k < 32; ++k) { const f32x4 wv = *(const f32x4*)(wp + (size_t)k * 9216);
                    const float c0 = cp[kw * 32 + k], c1 = cp[1024 + kw * 32 + k];
                    const float s0 = c0 / (1.0f + expf(-c0)), s1 = c1 / (1.0f + expf(-c1));
                    a0 = a0 + wv * s0; a1 = a1 + wv * s1; }
                *(f32x4*)(MODP + ((size_t)(kw * 2 + l) * 2 + 0) * 9216 + jb * 256 + 4 * lane) = a0;
                *(f32x4*)(MODP + ((size_t)(kw * 2 + l) * 2 + 1) * 9216 + jb * 256 + 4 * lane) = a1; } }
    }
    GRID_BAR();
    { bool even = (G == 256);
#pragma unroll
        for (int j = 0; j < 8; ++j) even = even && (__hip_atomic_load((unsigned*)(ctl + CW_XRANK) + 64 * j, __ATOMIC_RELAXED, __HIP_MEMORY_SCOPE_AGENT) == 32u);
        loc_ok = even; if (even) cv = (int)(bar.x & 7u) + 8 * (int)MISC[16];
        cv = __builtin_amdgcn_readfirstlane(cv); }
    const int gm_ = (cv >> 3) & 7, gq_ = cv >> 6;
    const int hp = (G == 256) ? 2 * (16 * (cv & 7) + 8 * (gq_ >> 1) + gm_) + (gq_ & 1) : bx;
    lb_cnt = (unsigned*)(ctl + CW_LBAR) + 128 * (8 * (cv & 7) + gm_); lb_gen = lb_cnt + 64;
    const int gwm = hp * NWAVES + wave;
    {
        const float* MODP = (const float*)(ws + WS_MODP);
        const int per = (2 * 3 * 2 * 1024 + G - 1) / G;
        for (int t = bx * per + tid; tid < per && t < 2 * 3 * 2 * 1024 && t < (bx + 1) * per; t += NTHR) {
            const int c = t & 1023, b = (t >> 10) & 1, ls = t >> 11, l = ls / 3, s = ls % 3;
            float v[3];
#pragma unroll
            for (int q = 0; q < 3; ++q) { float pv[32];
#pragma unroll
                for (int kw = 0; kw < 32; ++kw) pv[kw] = MODP[((size_t)(kw * 2 + l) * 2 + b) * 9216 + s * 3072 + q * 1024 + c];
                float acc = args.in[I_ADAB][l * 9216 + s * 3072 + q * 1024 + c];
#pragma unroll
                for (int kw = 0; kw < 32; ++kw) acc += pv[kw];
                v[q] = acc; }
            const float resw = (s == 1) ? 1.0f : 0.5f;
            float* p = PAR + ((size_t)(l * 3 + s) * 2 + b) * 3072 + c;
            p[0] = resw * (1.0f + v[2]) * args.in[I_NPOST][(l * 3 + s) * 1024 + c];
            p[1024] = args.in[I_NPRE][(l * 3 + s) * 1024 + c] * (1.0f + v[1]);
            p[2048] = v[0];
        }
    }
    {
        LAS float* scr = (LAS float*)(lds + wave * 16384);
        constexpr int NITEMS = 4 * (D / 64) * (2 * FF / 32) + 4 * (FF / 64) * (D / 32) + 2 * (D / 64) * (2048 / 32) + 2 * (D / 64) * (D / 32);
        if (gw < NITEMS) {
            TItem cur = p0_decode(args, ws, gw); float v[32]; p0_item_load(cur, lane, v);
#pragma unroll 1
            for (int it = gw; it < NITEMS; it += NGW) {
                const int nit = it + NGW; const bool more = nit < NITEMS;
                TItem nxt = cur; float vn[32];
                if (more) { nxt = p0_decode(args, ws, nit); p0_item_load(nxt, lane, vn); }
                p0_item_store(cur, lane, v, scr);
                if (more) {
#pragma unroll
                    for (int i = 0; i < 32; ++i) v[i] = vn[i];
                    cur = nxt; }
            }
        }
        { bf16* WSB = (bf16*)(ws + WS_WSB); const float* wsp = args.in[I_CWS];
            for (int e = bx * NTHR + tid; e < 8 * 128 * 128; e += G * NTHR) { const int s = e & 127, t = (e >> 7) & 127; WSB[e] = (bf16)f2bf(s <= t ? wsp[e] : 0.f); } }
        { bf16* GWT = (bf16*)(ws + WS_GWT); const float* gp = args.in[I_AGW];
            for (int e = bx * NTHR + tid; e < 8 * 128 * 64; e += G * NTHR) { const int d = e & 63, ee = (e >> 6) & 127, h = e >> 13; GWT[e] = (bf16)f2bf(gp[((size_t)h * 64 + d) * 128 + ee]); } }
    }
    GRID_BAR();
    trans_phase<false, true, 0, 1>(gwm, NGW, lane, args.in[I_X], XB, nullptr, nullptr, nullptr, PARP(0, 0, 1), PARP(0, 0, 2), XN);
    LOC_BAR();

#pragma unroll 1
    for (int l = 0; l < 2; ++l) {
        unsigned char* wl = ws + WS_W + (size_t)l * LAYER_W_BYTES;
#pragma unroll 1
        for (int s = 0; s < 3; ++s) {
            if (s != 1) {
                const int fi = s >> 1;
                if (l == 0 && s == 2) {
                    if (tid == 0) { unsigned sp_ = 0u; while (__hip_atomic_load((unsigned*)(ctl + CW_M1DONE), __ATOMIC_RELAXED, __HIP_MEMORY_SCOPE_AGENT) < (unsigned)G) { __builtin_amdgcn_s_sleep(2); if (++sp_ > (1u << 24)) break; } }
                    __syncthreads(); }
                { pg8::Gemm g{XN, (const bf16*)(wl + LW_W13 + (size_t)fi * W13_BYTES), M, 2 * FF, D}; pg8::StaticOrder S; S.init(M, 2 * FF, G, cv);
                    pg8::EpiX<1> E{ACT, FF, nullptr, nullptr, nullptr};
                    pg8::gemm_phase<pg8::EpiX<1>, pg8::StaticOrder, true, true>(lds, g, S, E); }
                LOC_BAR();
                { pg8::Gemm g{ACT, (const bf16*)(wl + LW_W2 + (size_t)fi * W2_BYTES), M, D, FF}; pg8::StaticOrder S; S.init(M, D, G, cv);
                    pg8::EpiX<2> E{YB, D, nullptr, ST0, nullptr};
                    pg8::gemm_phase<pg8::EpiX<2>, pg8::StaticOrder, true, true>(lds, g, S, E); }
                LOC_BAR();
            } else if (l == 0) {
                { pg8::Gemm g{XN, (const bf16*)(wl + LW_WIN), M, 2048, D}; pg8::StaticOrder S; S.init(M, 2048, G, cv);
                    pg8::EpiX<0> E{ACT, 2048, nullptr, nullptr, nullptr};
                    pg8::gemm_phase<pg8::EpiX<0>, pg8::StaticOrder, true, true>(lds, g, S, E); }
                GRID_BAR();
                for (int ci = hp; ci < NCHUNK; ci += G) m1_partA<0>(args, ws, lds, ci, wave, lane);
                asm volatile("s_waitcnt vmcnt(0)" ::: "memory"); __syncthreads();
                if (tid == 0) __hip_atomic_fetch_add((unsigned*)(ctl + CW_M1PUB), 1u, __ATOMIC_RELAXED, __HIP_MEMORY_SCOPE_AGENT);
                for (int ci = hp; ci < NCHUNK; ci += G) m1_partB(args, ws, ci, wave, lane);
                if (tid == 0) { unsigned sp_ = 0u; while (__hip_atomic_load((unsigned*)(ctl + CW_M1PUB), __ATOMIC_RELAXED, __HIP_MEMORY_SCOPE_AGENT) < (unsigned)G) { __builtin_amdgcn_s_sleep(2); if (++sp_ > (1u << 24)) break; }
                    __builtin_amdgcn_fence(__ATOMIC_ACQUIRE, "agent"); asm volatile("s_waitcnt vmcnt(0)" ::: "memory"); }
                __syncthreads();
                for (int ci = hp; ci < NCHUNK; ci += G) m1_partA<1>(args, ws, lds, ci, wave, lane);
                asm volatile("s_waitcnt vmcnt(0)" ::: "memory"); __syncthreads();
                if (tid == 0) __hip_atomic_fetch_add((unsigned*)(ctl + CW_M1DONE), 1u, __ATOMIC_RELAXED, __HIP_MEMORY_SCOPE_AGENT);
                LOC_BAR();
                { pg8::Gemm g{XN, (const bf16*)(wl + LW_WOUT), M, D, D}; pg8::StaticOrder S; S.init(M, D, G, cv);
                    pg8::EpiX<2> E{YB, D, nullptr, ST0, nullptr};
                    pg8::gemm_phase<pg8::EpiX<2>, pg8::StaticOrder, true, true>(lds, g, S, E); }
                LOC_BAR();
            } else {
                { pg8::Gemm g{XN, (const bf16*)(wl + LW_WIN), M, 2048, D}; pg8::StaticOrder S; S.init(M, 2048, G, cv);
                    pg8::EpiX<3> E{ACT, 2048, args.in[I_CBIN], ST1, ST2};
                    pg8::gemm_phase<pg8::EpiX<3>, pg8::StaticOrder, true, true>(lds, g, S, E); }
                LOC_BAR();
                for (int ci = hp; ci < NCHUNK; ci += G) sg_chunk(args, ws, lds, ci, wave, lane, tid);
                LOC_BAR();
                { pg8::Gemm g{XN, (const bf16*)(wl + LW_WOUT), M, D, D}; pg8::StaticOrder S; S.init(M, D, G, cv);
                    pg8::EpiX<2> E{YB, D, nullptr, ST0, nullptr};
                    pg8::gemm_phase<pg8::EpiX<2>, pg8::StaticOrder, true, true>(lds, g, S, E); }
                LOC_BAR();
            }
            if (l == 1 && s == 2) trans_phase<true, false, 1, 2>(gwm, NGW, lane, XB, args.out, YB, ST0, PARP(l, s, 0), nullptr, nullptr, nullptr);
            else { const int nl = (s == 2) ? l + 1 : l, ns = (s == 2) ? 0 : s + 1;
                trans_phase<true, true, 1, 1>(gwm, NGW, lane, XB, XB, YB, ST0, PARP(l, s, 0), PARP(nl, ns, 1), PARP(nl, ns, 2), XN);
                LOC_BAR(); }
        }
    }
    cg::this_grid().sync();
}

extern "C" void kernel_launch(void* const* d_in, const int* in_sizes, int n_in, void* d_out, int out_size, void* d_ws, size_t ws_size, hipStream_t stream) {
    static int grid = 0;
    if (grid == 0) {
        if (n_in != 26 || in_sizes[0] != M * D || out_size != M * D || ws_size < WS_END) { fprintf(stderr, "kernel_launch: unexpected shapes (n_in %d, in0 %d, out %d, ws %zu)\n", n_in, n_in > 0 ? in_sizes[0] : -1, out_size, ws_size); grid = -1; return; }
        int dev = 0, cus = 0, per_cu = 0;
        if (hipGetDevice(&dev) != hipSuccess || hipDeviceGetAttribute(&cus, hipDeviceAttributeMultiprocessorCount, dev) != hipSuccess) { grid = -1; return; }
        if (hipFuncSetAttribute((const void*)mega_fwd, hipFuncAttributeMaxDynamicSharedMemorySize, LDS_BYTES) != hipSuccess) { fprintf(stderr, "kernel_launch: hipFuncSetAttribute failed\n"); grid = -1; return; }
        if (hipOccupancyMaxActiveBlocksPerMultiprocessor(&per_cu, (const void*)mega_fwd, NTHR, LDS_BYTES) != hipSuccess || per_cu < 1) { fprintf(stderr, "kernel_launch: occupancy query says %d\n", per_cu); per_cu = 1; }
        (void)hipGetLastError();
        grid = cus;
    }
    if (grid < 0) return;
    (void)hipMemsetAsync((char*)d_ws + WS_CTL, 0, CTL_ZERO_BYTES, stream);
    Args a{};
    for (int i = 0; i < 26; ++i) a.in[i] = (const float*)d_in[i];
    a.out = (float*)d_out; a.ws = (unsigned char*)d_ws;
    void* kargs[] = {&a};
    const hipError_t le = hipLaunchCooperativeKernel((const void*)mega_fwd, dim3(grid), dim3(NTHR), kargs, LDS_BYTES, stream);
    if (le != hipSuccess) fprintf(stderr, "kernel_launch: cooperative launch failed: %s (grid %d)\n", hipGetErrorName(le), grid);
}
```

```cpp
#include <hip/hip_runtime.h>
#include <hip/hip_cooperative_groups.h>
#include <cstdio>
#include <cstdint>
namespace cg = cooperative_groups;
namespace pg8 {
#define PG8_LAS __attribute__((address_space(3)))
typedef unsigned short bf16_t;
typedef short bf16x8 __attribute__((ext_vector_type(8)));
typedef float f32x4 __attribute__((ext_vector_type(4)));
typedef unsigned u32x4 __attribute__((ext_vector_type(4)));
constexpr int BM = 256, BK = 64, HALF = 128, HTB = HALF * BK * 2  , STAGE_BYTES = 8 * HTB, NXCD = 8, WGM = 8;

__host__ __device__ __forceinline__ int lds_byte(int r, int c) { const int st = (r >> 4) * 2 + (c >> 5), rr = r & 15, cc = c & 31, ob = rr * 64 + cc * 2; return st * 1024 + (ob ^ (((ob >> 9) & 1) << 5)); }
__host__ __device__ __forceinline__ void stage_rc(int b, int& R, int& C) { const int st = b / 1024, sb = b % 1024, swz = sb ^ (((sb >> 9) & 1) << 5); R = (st >> 1) * 16 + swz / 64; C = (st & 1) * 32 + (swz % 64) / 2; }
__host__ __device__ __forceinline__ int perm32(int rho) { const int n = rho >> 4, i = rho & 15; return 8 * (i >> 2) + 4 * n + (i & 3); }

struct Unit { int pm, pn; };
struct Gemm { const bf16_t* A; const bf16_t* Bt; int M, N, K; };

struct StaticOrder {
    int nM, nN, nwg, G, c;
    __host__ __device__ void init(int M, int N, int G_, int c_) { nM = M / BM; nN = N / BM; nwg = nM * nN; G = G_; c = c_; }
    __host__ __device__ bool next(int i, Unit& u) const {
        const long L = (long)i * G + c; if (L >= nwg) return false;
        int wgid = (int)L; { const int q = nwg / NXCD, r = nwg % NXCD, xcd = wgid % NXCD, off = wgid / NXCD; wgid = (xcd < r ? xcd * (q + 1) : r * (q + 1) + (xcd - r) * q) + off; }
        const int nig = WGM * nN, gid = wgid / nig, fm = gid * WGM, gsz = (nM - fm) < WGM ? (nM - fm) : WGM;
        u.pm = fm + ((wgid % nig) % gsz); u.pn = (wgid % nig) / gsz; return true;
    }
    __device__ __forceinline__ void a_ready(const Unit&) const {}
    __device__ __forceinline__ void done(const Unit&) const {}
};

__device__ __forceinline__ unsigned cvt_pk_bf16(float lo, float hi) { unsigned r; asm volatile("v_cvt_pk_bf16_f32 %0, %1, %2" : "=v"(r) : "v"(lo), "v"(hi)); return r; }
typedef float f32x2 __attribute__((ext_vector_type(2)));
__device__ __forceinline__ float fast_sigmoid(float x) { return __builtin_amdgcn_rcpf(1.0f + __expf(-x)); }
__device__ __forceinline__ float gelu_tanh(float x) { const float u = 1.5957691216f * (x + 0.044715f * x * x * x); return x * fast_sigmoid(u); }
template <int MODE> struct EpiX {
    static constexpr bool PERM = true, AFTER_DRAIN = false;
    bf16_t* O; int ldc; const float* bias; float* st0; float* st1;
    __device__ __forceinline__ void operator()(const f32x4 (&acc)[2][2][4][2], const Unit& u, int wr, int wc, int fr, int fq) const {
        const int row0 = u.pm * BM + wr * 64 + fr;
        if constexpr (MODE == 1) {
            const int col0 = u.pn * HALF + wc * 32 + 8 * fq;
#pragma unroll
            for (int ai = 0; ai < 2; ++ai)
#pragma unroll
                for (int m = 0; m < 4; ++m) { bf16_t* rowp = O + (size_t)(row0 + ai * HALF + m * 16) * ldc + col0;
                    const f32x4 g0 = acc[ai][0][m][0], g1 = acc[ai][0][m][1], u0 = acc[ai][1][m][0], u1 = acc[ai][1][m][1];
                    float r[8];
#pragma unroll
                    for (int e = 0; e < 4; ++e) { r[e] = g0[e] * fast_sigmoid(g0[e]) * u0[e]; r[4 + e] = g1[e] * fast_sigmoid(g1[e]) * u1[e]; }
                    u32x4 w; w.x = cvt_pk_bf16(r[0], r[1]); w.y = cvt_pk_bf16(r[2], r[3]); w.z = cvt_pk_bf16(r[4], r[5]); w.w = cvt_pk_bf16(r[6], r[7]);
                    *(u32x4*)rowp = w; }
        } else {
            const int col0 = u.pn * BM + wc * 32 + 8 * fq;
            f32x4 bv[2][2];
#pragma unroll
            for (int bj = 0; bj < 2; ++bj)
#pragma unroll
                for (int n = 0; n < 2; ++n) bv[bj][n] = (MODE == 3) ? *(const f32x4*)(bias + col0 + bj * HALF + 4 * n) : (f32x4){0.f, 0.f, 0.f, 0.f};
#pragma unroll
            for (int ai = 0; ai < 2; ++ai)
#pragma unroll
                for (int m = 0; m < 4; ++m) { const int row = row0 + ai * HALF + m * 16; bf16_t* rowp = O + (size_t)row * ldc + col0;
                    float s1 = 0.f, s2 = 0.f;
#pragma unroll
                    for (int bj = 0; bj < 2; ++bj) { f32x4 v0 = acc[ai][bj][m][0], v1 = acc[ai][bj][m][1];
                        if constexpr (MODE == 3) { v0 = v0 + bv[bj][0]; v1 = v1 + bv[bj][1];
#pragma unroll
                            for (int e = 0; e < 4; ++e) { v0[e] = gelu_tanh(v0[e]); v1[e] = gelu_tanh(v1[e]); } }
                        if constexpr (MODE == 2 || MODE == 3) {
#pragma unroll
                            for (int e = 0; e < 4; ++e) { s1 += v0[e] + v1[e]; s2 += v0[e] * v0[e] + v1[e] * v1[e]; } }
                        u32x4 w; w.x = cvt_pk_bf16(v0[0], v0[1]); w.y = cvt_pk_bf16(v0[2], v0[3]); w.z = cvt_pk_bf16(v1[0], v1[1]); w.w = cvt_pk_bf16(v1[2], v1[3]);
                        *(u32x4*)(rowp + bj * HALF) = w; }
                    if constexpr (MODE == 2) { s2 += __shfl_xor(s2, 16); s2 += __shfl_xor(s2, 32); if (fq == 0) st0[(size_t)row * 16 + u.pn * 4 + wc] = s2; }
                    if constexpr (MODE == 3) { if (u.pn >= 4) { s1 += __shfl_xor(s1, 16); s1 += __shfl_xor(s1, 32); s2 += __shfl_xor(s2, 16); s2 += __shfl_xor(s2, 32);
                            if (fq == 0) { st0[(size_t)row * 16 + (u.pn - 4) * 4 + wc] = s1; st1[(size_t)row * 16 + (u.pn - 4) * 4 + wc] = s2; } } }
                }
        }
    }
};
template <class Epi, class Sched, bool ALIGN_EPI = false, bool SP2 = false>
__device__ __forceinline__ void gemm_phase(PG8_LAS unsigned char* lds, const Gemm g, const Sched& S, const Epi& E) {
    int tid_ = threadIdx.x; asm volatile("" : "+v"(tid_));
    const int tid = tid_, wid = __builtin_amdgcn_readfirstlane(tid >> 6), lane = tid & 63, wr = wid >> 2, wc = wid & 3, fr = lane & 15, fq = lane >> 4;
    const int K = g.K, nt = K / BK;
    unsigned voffA[2], voffB[2];
#pragma unroll
    for (int i = 0; i < 2; ++i) { int R, C; stage_rc(tid * 16 + i * 8192, R, C); const int Rb = Epi::PERM ? ((R & ~31) + perm32(R & 31)) : R;
        voffA[i] = (unsigned)(R * K + C) * 2u; voffB[i] = (unsigned)(Rb * K + C) * 2u; }
    const size_t kstep = (size_t)(BK * 2);
    const size_t hstep = (size_t)HALF * K * 2;
    const size_t tstep = 2 * hstep;
    const unsigned ldsw = (unsigned)wid * 1024u;
    const int aoff = lds_byte(wr * 64 + fr, fq * 8), boff = lds_byte(wc * 32 + fr, fq * 8);
#define PG8_SA(b, h) (((b) * 2 + (h)) * HTB)
#define PG8_SB(b, h) ((4 + (b) * 2 + (h)) * HTB)
#define PG8_STAGE(bufoff, gbase, voff) do { _Pragma("unroll") for (int _i = 0; _i < 2; ++_i) \
        __builtin_amdgcn_global_load_lds((const unsigned*)((const char*)(gbase) + (voff)[_i]), (PG8_LAS unsigned*)(lds + (bufoff) + ldsw + _i * 8192), 16, 0, 0); } while (0)
#define PG8_LDA(dst, b, h) do { _Pragma("unroll") for (int m = 0; m < 4; ++m) _Pragma("unroll") for (int k = 0; k < 2; ++k) dst[m][k] = *(const PG8_LAS bf16x8*)(lds + PG8_SA(b, h) + aoff + m * 2048 + k * 1024); } while (0)
#define PG8_LDB(dst, b, h) do { _Pragma("unroll") for (int n = 0; n < 2; ++n) _Pragma("unroll") for (int k = 0; k < 2; ++k) dst[n][k] = *(const PG8_LAS bf16x8*)(lds + PG8_SB(b, h) + boff + n * 2048 + k * 1024); } while (0)
#define PG8_MMA(ai, bj, At, Bt) do { __builtin_amdgcn_s_setprio(1); _Pragma("unroll") for (int m = 0; m < 4; ++m) _Pragma("unroll") for (int n = 0; n < 2; ++n) _Pragma("unroll") for (int k = 0; k < 2; ++k) \
        acc[ai][bj][m][n] = __builtin_amdgcn_mfma_f32_16x16x32_bf16(Bt[n][k], At[m][k], acc[ai][bj][m][n], 0, 0, 0); __builtin_amdgcn_s_setprio(0); } while (0)
#define PG8_WAIT_V(n) asm volatile("s_waitcnt vmcnt(" #n ")" ::: "memory")
#define PG8_WAIT_L(n) asm volatile("s_waitcnt lgkmcnt(" #n ")" ::: "memory")
#define PG8_BAR __builtin_amdgcn_s_barrier()
#define PG8_SCHED __builtin_amdgcn_sched_barrier(0)
    Unit cur, nxt; int ui = 0;
    if (!S.next(0, cur)) return;
    f32x4 acc[2][2][4][2];
#pragma unroll
    for (int a = 0; a < 2; ++a)
#pragma unroll
        for (int b = 0; b < 2; ++b)
#pragma unroll
            for (int m = 0; m < 4; ++m)
#pragma unroll
                for (int n = 0; n < 2; ++n) acc[a][b][m][n] = (f32x4){0.f, 0.f, 0.f, 0.f};
    bf16x8 At[4][2], B0[2][2], B1[2][2];
    const char* cA = (const char*)g.A + (size_t)cur.pm * tstep; const char* cB = (const char*)g.Bt + (size_t)cur.pn * tstep;
    S.a_ready(cur);
    if constexpr (SP2) {
        PG8_STAGE(PG8_SB(0, 0), cB, voffB); PG8_STAGE(PG8_SB(0, 1), cB + hstep, voffB); PG8_STAGE(PG8_SA(0, 0), cA, voffA); PG8_STAGE(PG8_SA(0, 1), cA + hstep, voffA);
        if (wr == 1) PG8_BAR;
        PG8_WAIT_V(2); PG8_BAR;
        PG8_STAGE(PG8_SB(1, 0), cB + kstep, voffB); PG8_STAGE(PG8_SA(1, 0), cA + kstep, voffA); PG8_STAGE(PG8_SB(1, 1), cB + hstep + kstep, voffB);
        PG8_WAIT_V(6); PG8_BAR;
    } else {
        PG8_STAGE(PG8_SB(0, 0), cB, voffB); PG8_STAGE(PG8_SA(0, 0), cA, voffA); PG8_STAGE(PG8_SB(0, 1), cB + hstep, voffB); PG8_STAGE(PG8_SA(0, 1), cA + hstep, voffA);
        if (wr == 1) PG8_BAR;
        PG8_WAIT_V(4); PG8_BAR;
        PG8_STAGE(PG8_SB(1, 0), cB + kstep, voffB); PG8_STAGE(PG8_SA(1, 0), cA + kstep, voffA); PG8_STAGE(PG8_SB(1, 1), cB + hstep + kstep, voffB);
        PG8_WAIT_V(6); PG8_BAR;
    }
    for (;;) {
        const bool has_next = S.next(ui + 1, nxt);
        const char* nA = has_next ? (const char*)g.A + (size_t)nxt.pm * tstep : cA; const char* nB = has_next ? (const char*)g.Bt + (size_t)nxt.pn * tstep : cB;
        for (int t = 0; t < nt; t += 2) {
            const bool last = (t == nt - 2);
            const char* a1 = cA + (size_t)(t + 1) * kstep;
            const char* a2 = last ? nA : cA + (size_t)(t + 2) * kstep; const char* b2 = last ? nB : cB + (size_t)(t + 2) * kstep;
            const char* a3 = a2 + kstep; const char* b3 = b2 + kstep;
            if (last && has_next) S.a_ready(nxt);
            if constexpr (SP2) {
            PG8_LDB(B0, 0, 0); PG8_LDB(B1, 0, 1); PG8_SCHED; PG8_LDA(At, 0, 0); PG8_STAGE(PG8_SA(1, 1), a1 + hstep, voffA);
            PG8_WAIT_V(8); PG8_WAIT_L(0); PG8_BAR; PG8_MMA(0, 0, At, B0); PG8_MMA(0, 1, At, B1); PG8_BAR; PG8_SCHED;
            PG8_LDA(At, 0, 1); PG8_STAGE(PG8_SB(0, 0), b2, voffB); PG8_STAGE(PG8_SB(0, 1), b2 + hstep, voffB); PG8_STAGE(PG8_SA(0, 0), a2, voffA);
            PG8_WAIT_V(8); PG8_WAIT_L(0); PG8_BAR; PG8_MMA(1, 0, At, B0); PG8_MMA(1, 1, At, B1); PG8_BAR; PG8_SCHED;
            PG8_LDB(B0, 1, 0); PG8_LDB(B1, 1, 1); PG8_SCHED; PG8_LDA(At, 1, 0); PG8_STAGE(PG8_SA(0, 1), a2 + hstep, voffA);
            PG8_WAIT_V(8); PG8_WAIT_L(0); PG8_BAR; PG8_MMA(0, 0, At, B0); PG8_MMA(0, 1, At, B1); PG8_BAR; PG8_SCHED;
            PG8_LDA(At, 1, 1); PG8_STAGE(PG8_SB(1, 0), b3, voffB); PG8_STAGE(PG8_SB(1, 1), b3 + hstep, voffB); PG8_STAGE(PG8_SA(1, 0), a3, voffA);
            PG8_WAIT_V(8); PG8_WAIT_L(0); PG8_BAR; PG8_MMA(1, 0, At, B0); PG8_MMA(1, 1, At, B1); PG8_BAR; PG8_SCHED;
            } else {
            PG8_LDB(B0, 0, 0); PG8_SCHED; PG8_LDA(At, 0, 0); PG8_STAGE(PG8_SA(1, 1), a1 + hstep, voffA);
            PG8_WAIT_L(8); PG8_BAR; PG8_WAIT_L(0); PG8_MMA(0, 0, At, B0); PG8_BAR; PG8_SCHED;
            PG8_LDB(B1, 0, 1); PG8_STAGE(PG8_SB(0, 0), b2, voffB);
            PG8_BAR; PG8_WAIT_L(0); PG8_MMA(0, 1, At, B1); PG8_BAR;
            PG8_LDA(At, 0, 1); PG8_STAGE(PG8_SA(0, 0), a2, voffA);
            PG8_BAR; PG8_WAIT_L(0); PG8_MMA(1, 0, At, B0); PG8_BAR; PG8_SCHED;
            PG8_STAGE(PG8_SB(0, 1), b2 + hstep, voffB);
            PG8_WAIT_V(6); PG8_BAR; PG8_MMA(1, 1, At, B1); PG8_BAR;
            PG8_LDB(B0, 1, 0); PG8_SCHED; PG8_LDA(At, 1, 0); PG8_STAGE(PG8_SA(0, 1), a2 + hstep, voffA);
            PG8_WAIT_L(8); PG8_BAR; PG8_WAIT_L(0); PG8_MMA(0, 0, At, B0); PG8_BAR; PG8_SCHED;
            PG8_LDB(B1, 1, 1); PG8_STAGE(PG8_SB(1, 0), b3, voffB);
            PG8_BAR; PG8_WAIT_L(0); PG8_MMA(0, 1, At, B1); PG8_BAR;
            PG8_LDA(At, 1, 1); PG8_STAGE(PG8_SA(1, 0), a3, voffA);
            PG8_BAR; PG8_WAIT_L(0); PG8_MMA(1, 0, At, B0); PG8_BAR; PG8_SCHED;
            PG8_STAGE(PG8_SB(1, 1), b3 + hstep, voffB);
            PG8_WAIT_V(6); PG8_BAR; PG8_MMA(1, 1, At, B1); PG8_BAR;
            }
        }
        if constexpr (ALIGN_EPI) { if (wr == 0) PG8_BAR; }
        if constexpr (!Epi::AFTER_DRAIN) { E(acc, cur, wr, wc, fr, fq); S.done(cur); }
        if (!has_next) break;
#pragma unroll
        for (int a = 0; a < 2; ++a)
#pragma unroll
            for (int b = 0; b < 2; ++b)
#pragma unroll
                for (int m = 0; m < 4; ++m)
#pragma unroll
                    for (int n = 0; n < 2; ++n) acc[a][b][m][n] = (f32x4){0.f, 0.f, 0.f, 0.f};
        cur = nxt; cA = nA; cB = nB; ++ui;
        if constexpr (ALIGN_EPI) { if (wr == 1) PG8_BAR; }
    }
    PG8_WAIT_V(0);
    if constexpr (!ALIGN_EPI) { if (wr == 0) PG8_BAR; }
    PG8_BAR;
    if constexpr (Epi::AFTER_DRAIN) { E.fused(acc, cur, wr, wc, fr, fq, lds, wid, lane); S.done(cur); }
#undef PG8_SA
#undef PG8_SB
#undef PG8_STAGE
#undef PG8_LDA
#undef PG8_LDB
#undef PG8_MMA
#undef PG8_WAIT_V
#undef PG8_WAIT_L
#undef PG8_BAR
#undef PG8_SCHED
}
}
#define GAS __attribute__((address_space(1)))
#define LAS __attribute__((address_space(3)))
typedef unsigned short bf16;
typedef unsigned v4u __attribute__((ext_vector_type(4)));
typedef float f32x4 __attribute__((ext_vector_type(4)));
typedef short bf16x8 __attribute__((ext_vector_type(8)));
typedef GAS unsigned gu32;
typedef GAS unsigned long long gu64;
#define RLX_AGENT __ATOMIC_RELAXED, __HIP_MEMORY_SCOPE_AGENT
#define LDS_WAIT() asm volatile("s_waitcnt lgkmcnt(0)" ::: "memory")
#define VM_WAIT() asm volatile("s_waitcnt vmcnt(0)" ::: "memory")
__device__ __forceinline__ unsigned long long rt() { return __builtin_amdgcn_s_memrealtime(); }
__device__ __forceinline__ unsigned f2bf(float f) { unsigned u = __builtin_bit_cast(unsigned, f); return (u + 0x7fffu + ((u >> 16) & 1u)) >> 16; }
__device__ __forceinline__ unsigned pk2(float lo, float hi) { return f2bf(lo) | (f2bf(hi) << 16); }
#define XB_TMO      128
#define XB_XCNT(j)  (256  + 64 * (j))
#define XB_XSUB(j)  (1280 + 64 * (j))
#define XB_XGEN(j)  (2304 + 64 * (j))
#define XB_TOP      3328
#define XB_TOPGEN   3392
#define XCD_BAR_WORDS 3456
#define XB_SPIN_CAP (1u << 18)

__device__ __forceinline__ unsigned xb_ld(unsigned* p)              { return __hip_atomic_load(p, __ATOMIC_RELAXED, __HIP_MEMORY_SCOPE_AGENT); }
__device__ __forceinline__ unsigned xb_add(unsigned* p, unsigned v) { return __hip_atomic_fetch_add(p, v, __ATOMIC_RELAXED, __HIP_MEMORY_SCOPE_AGENT); }
__device__ __forceinline__ unsigned xb_xcc_id() { return (unsigned)__builtin_amdgcn_s_getreg((3 << 11) | 20) & 0xFu; }
#define XB_SPIN(cond, bar) do { unsigned _sp = 0; while (cond) { __builtin_amdgcn_s_sleep(1); \
    if ((++_sp & 255u) == 0u) { if (xb_ld(&(bar)[XB_TMO])) break; if (_sp > XB_SPIN_CAP) { atomicAdd(&(bar)[XB_TMO], 1u); break; } } } } while (0)

struct XcdBarrier {
    unsigned* bar; unsigned x;
    volatile LAS unsigned* st;
};

__device__ __forceinline__ XcdBarrier xcd_barrier_post(unsigned* bar, volatile LAS unsigned* st) {
    XcdBarrier b; b.bar = bar; b.x = xb_xcc_id(); b.st = st;
    if (threadIdx.x == 0) (void)xb_add(&bar[XB_XCNT(b.x)], 1u);
    return b;
}
__device__ __forceinline__ void xcd_barrier_complete(unsigned* bar, unsigned x, unsigned& nloc, unsigned& nx) {
    const unsigned G = gridDim.x * gridDim.y * gridDim.z;
    unsigned sum, cnt, mine, sp = 0u;
    for (;;) {
        sum = 0u; cnt = 0u; mine = 0u;
#pragma unroll
        for (unsigned j = 0; j < 16; ++j) { const unsigned c = xb_ld(&bar[XB_XCNT(j)]); sum += c; cnt += (c > 0u) ? 1u : 0u; mine = (j == x) ? c : mine; }
        if (sum == G) break;
        __builtin_amdgcn_s_sleep(1);
        if ((++sp & 255u) == 0u) { if (xb_ld(&bar[XB_TMO])) break; if (sp > XB_SPIN_CAP) { atomicAdd(&bar[XB_TMO], 1u); break; } }
    }
    nloc = mine > 0u ? mine : 1u; nx = cnt > 0u ? cnt : 1u;
}

__device__ __forceinline__ void xcd_barrier(const XcdBarrier& b) {
    asm volatile("s_waitcnt vmcnt(0)" ::: "memory");
    __syncthreads();
    if (threadIdx.x == 0) {
        unsigned* bar = b.bar;
        __builtin_amdgcn_s_waitcnt(0);
        unsigned nloc = b.st[0], nx = b.st[1];
        if (nloc == 0u) { xcd_barrier_complete(bar, b.x, nloc, nx); b.st[0] = nloc; b.st[1] = nx; }
        const unsigned old = xb_add(&bar[XB_XSUB(b.x)], 1u);
        const unsigned gen = old / nloc;
        if (old + 1u == (gen + 1u) * nloc) {
            __builtin_amdgcn_fence(__ATOMIC_RELEASE, "agent");
            asm volatile("s_waitcnt vmcnt(0)" ::: "memory");
            const unsigned og = xb_add(&bar[XB_TOP], 1u);
            const unsigned tg = og / nx;
            if (og + 1u == (tg + 1u) * nx) xb_add(&bar[XB_TOPGEN], 1u);
            else XB_SPIN(xb_ld(&bar[XB_TOPGEN]) == tg, bar);
            __builtin_amdgcn_fence(__ATOMIC_ACQUIRE, "agent");
            xb_add(&bar[XB_XGEN(b.x)], 1u);
            asm volatile("s_waitcnt vmcnt(0)" ::: "memory");
        } else {
            XB_SPIN(xb_ld(&bar[XB_XGEN(b.x)]) == gen, bar);
            __builtin_amdgcn_fence(__ATOMIC_ACQUIRE, "agent");
            asm volatile("s_waitcnt vmcnt(0)" ::: "memory");
        }
    }
    __syncthreads();
}

constexpr int NWAVES = 8, NTHR = NWAVES * 64;
constexpr int BATCH = 2, SEQ = 16384, D = 1024, FF = 2816, M = BATCH * SEQ;
constexpr int NCHUNK = M / 128;
constexpr float EPS = 1e-6f;
constexpr size_t MiB = 1u << 20;
constexpr size_t WS_CTL = 0, CTL_ZERO_BYTES = 1 * MiB;
constexpr size_t WS_W = 1 * MiB;
constexpr size_t W13_BYTES = (size_t)2 * FF * D * 2, W2_BYTES = (size_t)D * FF * 2, WIN_BYTES = (size_t)2048 * D * 2, WOUT_BYTES = (size_t)D * D * 2;
constexpr size_t LW_W13 = 0, LW_W2 = 2 * W13_BYTES, LW_WIN = LW_W2 + 2 * W2_BYTES, LW_WOUT = LW_WIN + WIN_BYTES, LAYER_W_BYTES = LW_WOUT + WOUT_BYTES;
static_assert(LAYER_W_BYTES == 39 * MiB, "weights");
constexpr size_t WS_XN = 80 * MiB;
constexpr size_t WS_ACT = 144 * MiB;
constexpr size_t WS_PC = WS_ACT + 128 * MiB;
constexpr size_t WS_Y = 320 * MiB;
constexpr size_t WS_MISC = 384 * MiB;
constexpr size_t WS_ST0 = WS_MISC, WS_ST1 = WS_MISC + 2 * MiB, WS_ST2 = WS_MISC + 4 * MiB;
constexpr size_t WS_MODP = WS_MISC + 6 * MiB;
constexpr size_t WS_PAR = WS_MISC + 11 * MiB;
constexpr size_t WS_WSB = WS_MISC + 12 * MiB;
constexpr size_t WS_GWT = WS_MISC + 12 * MiB + 512 * 1024;
constexpr size_t WS_SUMM = WS_MISC + 13 * MiB;
constexpr size_t WS_XB = WS_MISC + 16 * MiB;
constexpr size_t WS_END = WS_XB + 64 * MiB;
static_assert(WS_W + 2 * LAYER_W_BYTES <= WS_XN && WS_PC + (size_t)M * 512 * 2 <= WS_Y, "d_ws map");
constexpr int CW_BAR = 4096, CW_XRANK = 32768, CW_LBAR = 40960, CW_M1PUB = 53248, CW_M1DONE = 53312;
constexpr int RING_BYTES = 131072, LDS_BYTES = 147456, LDSCTL_OFF = LDS_BYTES - 512, MISC_OFF = LDSCTL_OFF;

struct Args { const float* in[26]; float* out; unsigned char* ws; };
enum { I_X = 0, I_C, I_ADAW, I_ADAB, I_NPRE, I_NPOST, I_W13, I_W2, I_ABWIN, I_ACW, I_ACB, I_AGW, I_AGB, I_ALAM, I_BCW, I_BCB, I_BNG, I_BNB, I_ABWOUT, I_CWIN, I_CBIN, I_CNG, I_CNB, I_CWS, I_CBS, I_CWOUT };

__device__ __forceinline__ float dpp_row_shr(float v, int n) {
    const int iv = __builtin_bit_cast(int, v); int r;
    switch (n) { case 1: r = __builtin_amdgcn_update_dpp(0, iv, 0x111, 0xf, 0xf, true); break; case 2: r = __builtin_amdgcn_update_dpp(0, iv, 0x112, 0xf, 0xf, true); break;
                 case 4: r = __builtin_amdgcn_update_dpp(0, iv, 0x114, 0xf, 0xf, true); break; default: r = __builtin_amdgcn_update_dpp(0, iv, 0x118, 0xf, 0xf, true); break; }
    return __builtin_bit_cast(float, r);
}
__device__ __forceinline__ float row16_sum(float v) {
    v += dpp_row_shr(v, 1); v += dpp_row_shr(v, 2); v += dpp_row_shr(v, 4); v += dpp_row_shr(v, 8);
    return __builtin_bit_cast(float, __builtin_amdgcn_readlane(__builtin_bit_cast(int, v), 15));
}
__device__ __forceinline__ float wave_sum(float v) {
    v += dpp_row_shr(v, 1); v += dpp_row_shr(v, 2); v += dpp_row_shr(v, 4); v += dpp_row_shr(v, 8);
    v += __builtin_bit_cast(float, __builtin_amdgcn_update_dpp(0, __builtin_bit_cast(int, v), 0x142, 0xa, 0xf, false));
    v += __builtin_bit_cast(float, __builtin_amdgcn_update_dpp(0, __builtin_bit_cast(int, v), 0x143, 0xc, 0xf, false));
    return __builtin_bit_cast(float, __builtin_amdgcn_readlane(__builtin_bit_cast(int, v), 63));
}
__device__ __forceinline__ float neg_expm1(float x) {
    const float p = x * (1.0f + x * (0.5f + x * (0.16666667f + x * (0.041666668f + x * (0.0083333338f + x * 0.0013888889f)))));
    return (x > -0.25f) ? -p : 1.0f - __expf(x);
}
__device__ __forceinline__ float bf2f(unsigned h) { return __uint_as_float(h << 16); }
__device__ __forceinline__ float bflo(unsigned w) { return __uint_as_float(w << 16); }
__device__ __forceinline__ float bfhi(unsigned w) { return __uint_as_float(w & 0xffff0000u); }
__device__ __forceinline__ float fsig(float x) { return __builtin_amdgcn_rcpf(1.0f + __expf(-x)); }
__device__ __forceinline__ float gelu_t(float x) { const float u = 1.5957691216f * (x + 0.044715f * x * x * x); return x * fsig(u); }
typedef unsigned u32x2 __attribute__((ext_vector_type(2)));

struct TItem { const float* src; bf16* dst; int K, N; };
__device__ __forceinline__ TItem p0_decode(const Args& args, unsigned char* ws, int it) {
    constexpr int I13 = (D / 64) * (2 * FF / 32), I2 = (FF / 64) * (D / 32), IWIN = (D / 64) * (2048 / 32), IWOUT = (D / 64) * (D / 32);
    const float* W; bf16* WT; int K, N, mode = 0; int r = it;
    if (r < 4 * I13) { const int mi = r / I13; r -= mi * I13; W = args.in[I_W13] + (size_t)mi * D * 2 * FF; K = D; N = 2 * FF; mode = 1; WT = (bf16*)(ws + WS_W + (size_t)(mi >> 1) * LAYER_W_BYTES + LW_W13 + (size_t)(mi & 1) * W13_BYTES); }
    else { r -= 4 * I13;
        if (r < 4 * I2) { const int mi = r / I2; r -= mi * I2; W = args.in[I_W2] + (size_t)mi * FF * D; K = FF; N = D; WT = (bf16*)(ws + WS_W + (size_t)(mi >> 1) * LAYER_W_BYTES + LW_W2 + (size_t)(mi & 1) * W2_BYTES); }
        else { r -= 4 * I2;
            if (r < IWIN) { W = args.in[I_ABWIN]; K = D; N = 2048; WT = (bf16*)(ws + WS_W + LW_WIN); }
            else { r -= IWIN;
                if (r < IWIN) { W = args.in[I_CWIN]; K = D; N = 2048; WT = (bf16*)(ws + WS_W + LAYER_W_BYTES + LW_WIN); }
                else { r -= IWIN;
                    if (r < IWOUT) { W = args.in[I_ABWOUT]; K = D; N = D; WT = (bf16*)(ws + WS_W + LW_WOUT); }
                    else { r -= IWOUT; W = args.in[I_CWOUT]; K = D; N = D; WT = (bf16*)(ws + WS_W + LAYER_W_BYTES + LW_WOUT); } } } } }
    const int nblk = N / 32, kb = r / nblk, nb = r % nblk, k0 = 64 * kb, n0 = 32 * nb;
    int rowbase = n0;
    if (mode == 1) { if (n0 < FF) rowbase = 256 * (n0 >> 7) + (n0 & 127); else { const int c = n0 - FF; rowbase = 256 * (c >> 7) + 128 + (c & 127); } }
    TItem t; t.src = W + (size_t)k0 * N + n0; t.dst = WT + (size_t)rowbase * K + k0; t.K = K; t.N = N; return t;
}
__device__ __forceinline__ void p0_item_load(const TItem& t, int lane, float (&v)[32]) {
#pragma unroll
    for (int i = 0; i < 32; ++i) v[i] = __builtin_nontemporal_load(t.src + (size_t)(2 * i + (lane >> 5)) * t.N + (lane & 31));
}
__device__ __forceinline__ void p0_item_store(const TItem& t, int lane, const float (&v)[32], LAS float* scr) {
#pragma unroll
    for (int i = 0; i < 32; ++i) scr[(2 * i + (lane >> 5)) * 33 + (lane & 31)] = v[i];
    LDS_WAIT(); asm volatile("" ::: "memory");
    const int c = lane & 7;
#pragma unroll
    for (int j = 0; j < 4; ++j) { const int n = (lane >> 3) + 8 * j; const LAS float* s = scr + (8 * c) * 33 + n;
        v4u o; o.x = pk2(s[0 * 33], s[1 * 33]); o.y = pk2(s[2 * 33], s[3 * 33]); o.z = pk2(s[4 * 33], s[5 * 33]); o.w = pk2(s[6 * 33], s[7 * 33]);
        *(GAS v4u*)(t.dst + (size_t)n * t.K + 8 * c) = o; }
    LDS_WAIT(); asm volatile("" ::: "memory");
}

template <bool RES, bool NORM, int XIN, int XOUT>
__device__ __forceinline__ void trans_phase(int gw, int NGW, int lane_, const void* xin_, void* xout_, const bf16* Y, const float* st,
                                            const float* A1p, const float* A2p, const float* A3p, bf16* XN) {
    int lane = lane_; asm volatile("" : "+v"(lane));
    for (int blk = gw; blk < M / 16; blk += NGW) {
        const int rbase = blk * 16, b = rbase / SEQ;
        f32x4 A1[4], A2[4], A3[4];
#pragma unroll
        for (int j = 0; j < 4; ++j) {
            if (RES) A1[j] = *(const f32x4*)(A1p + b * 3072 + 4 * lane + 256 * j);
            if (NORM) { A2[j] = *(const f32x4*)(A2p + b * 3072 + 4 * lane + 256 * j); A3[j] = *(const f32x4*)(A3p + b * 3072 + 4 * lane + 256 * j); }
        }
#pragma unroll 1
        for (int r4 = 0; r4 < 16; r4 += 4) {
            f32x4 xv[4][4]; u32x2 xb[4][4]; u32x2 yv[4][4]; float sp[4];
#pragma unroll
            for (int r = 0; r < 4; ++r) { const size_t row = (size_t)(rbase + r4 + r);
#pragma unroll
                for (int j = 0; j < 4; ++j) { if (XIN == 0) xv[r][j] = __builtin_nontemporal_load((const f32x4*)((const float*)xin_ + row * D + 4 * lane + 256 * j)); else xb[r][j] = __builtin_nontemporal_load((const u32x2*)((const bf16*)xin_ + row * D + 4 * lane + 256 * j)); }
                if (RES) {
#pragma unroll
                    for (int j = 0; j < 4; ++j) yv[r][j] = __builtin_nontemporal_load((const u32x2*)(Y + row * D + 4 * lane + 256 * j));
                    sp[r] = st[row * 16 + (lane & 15)]; } }
#pragma unroll
            for (int r = 0; r < 4; ++r) { const size_t row = (size_t)(rbase + r4 + r);
                if (XIN == 1) {
#pragma unroll
                    for (int j = 0; j < 4; ++j) xv[r][j] = (f32x4){bflo(xb[r][j].x), bfhi(xb[r][j].x), bflo(xb[r][j].y), bfhi(xb[r][j].y)}; }
                if (RES) {
                    const float ss = row16_sum(sp[r]);
                    const float rstd = rsqrtf(ss * (1.0f / D) + EPS);
#pragma unroll
                    for (int j = 0; j < 4; ++j) { const f32x4 y = (f32x4){bflo(yv[r][j].x), bfhi(yv[r][j].x), bflo(yv[r][j].y), bfhi(yv[r][j].y)};
                        xv[r][j] = xv[r][j] + A1[j] * y * rstd; }
                }
                if (XOUT == 2) {
#pragma unroll
                    for (int j = 0; j < 4; ++j) __builtin_nontemporal_store(xv[r][j], (f32x4*)((float*)xout_ + row * D + 4 * lane + 256 * j)); }
                if (XOUT == 1) {
#pragma unroll
                    for (int j = 0; j < 4; ++j) { u32x2 w; w.x = pg8::cvt_pk_bf16(xv[r][j].x, xv[r][j].y); w.y = pg8::cvt_pk_bf16(xv[r][j].z, xv[r][j].w);
                        __builtin_nontemporal_store(w, (u32x2*)((bf16*)xout_ + row * D + 4 * lane + 256 * j)); } }
                if (NORM) {
                    float q = 0.f;
#pragma unroll
                    for (int j = 0; j < 4; ++j) q += (xv[r][j].x * xv[r][j].x + xv[r][j].y * xv[r][j].y) + (xv[r][j].z * xv[r][j].z + xv[r][j].w * xv[r][j].w);
                    q = wave_sum(q);
                    const float r2 = rsqrtf(q * (1.0f / D) + EPS);
#pragma unroll
                    for (int j = 0; j < 4; ++j) { const f32x4 h = xv[r][j] * r2 * A2[j] + A3[j];
                        u32x2 w; w.x = pg8::cvt_pk_bf16(h.x, h.y); w.y = pg8::cvt_pk_bf16(h.z, h.w);
                        *(u32x2*)(XN + row * D + 4 * lane + 256 * j) = w; }
                }
            }
        }
    }
}

template <int PASS>
__device__ __forceinline__ void m1_partA(const Args& a, unsigned char* ws, LAS unsigned char* lds, int ci, int w, int lane_) {
    int lane = lane_; asm volatile("" : "+v"(lane));
    const bf16* Z = (const bf16*)(ws + WS_ACT); float* SUMM = (float*)(ws + WS_SUMM); bf16* YCAT = (bf16*)(ws + WS_XN);
    const int ch = w * 64 + lane, row0 = ci * 128; const bool first = (ci % (SEQ / 128)) == 0;
    LAS bf16* xcl = (LAS bf16*)(lds + w * 10752);
    LAS float* gl = (LAS float*)(lds + w * 10752 + 2304);
    const int fr = lane & 15, fq = lane >> 4;
    const bf16* GWT = (const bf16*)(ws + WS_GWT);
    bf16x8 gB[8][2];
#pragma unroll
    for (int et = 0; et < 8; ++et)
#pragma unroll
        for (int ks = 0; ks < 2; ++ks) gB[et][ks] = *(const bf16x8*)(GWT + ((size_t)w * 128 + et * 16 + fr) * 64 + ks * 32 + 8 * fq);
    const float* cwp = a.in[I_ACW];
    const float cw0 = cwp[ch], cw1 = cwp[512 + ch], cw2 = cwp[1024 + ch], cw3 = cwp[1536 + ch], cb = a.in[I_ACB][ch];
    const float lam = a.in[I_ALAM][ch];
    const float c8 = -8.0f * log1pf(expf(-lam));
    const bool small_all = __builtin_amdgcn_ballot_w64(c8 > -0.25f) == ~0ull;
    const float gbr = a.in[I_AGB][w * 128 + lane], gbi = a.in[I_AGB][w * 128 + 64 + lane];
    const bf16* zx = Z + 512 + ch; const bf16* zg = Z + ch;
    float xm3 = 0.f, xm2 = 0.f, xm1 = 0.f;
    if (!first) { xm3 = bf2f(zx[(size_t)(row0 - 3) * 2048]); xm2 = bf2f(zx[(size_t)(row0 - 2) * 2048]); xm1 = bf2f(zx[(size_t)(row0 - 1) * 2048]); }
    float hl = 0.f, P = 1.f;
    if (PASS == 1) { const int c0 = (ci / (SEQ / 128)) * (SEQ / 128);
#pragma unroll 32
        for (int c = c0; c < ci; ++c) { const pg8::f32x2 sm = *(const pg8::f32x2*)(SUMM + ((size_t)c * 512 + ch) * 2); hl = sm.x * hl + sm.y; } }
    unsigned short nx[16], ng[16];
#pragma unroll
    for (int i = 0; i < 16; ++i) { nx[i] = __builtin_nontemporal_load(zx + (size_t)(row0 + i) * 2048); if (PASS == 1) ng[i] = __builtin_nontemporal_load(zg + (size_t)(row0 + i) * 2048); }
#pragma unroll 1
    for (int sc = 0; sc < 8; ++sc) {
        float xc[16]; float ag[16];
#pragma unroll
        for (int i = 0; i < 16; ++i) { const float x = bf2f(nx[i]); xc[i] = cb + cw0 * xm3 + cw1 * xm2 + cw2 * xm1 + cw3 * x; xm3 = xm2; xm2 = xm1; xm1 = x;
            if (PASS == 1) ag[i] = bf2f(ng[i]);
            xcl[i * 72 + lane] = (bf16)f2bf(xc[i]); }
        if (sc < 7) {
#pragma unroll
            for (int i = 0; i < 16; ++i) { nx[i] = __builtin_nontemporal_load(zx + (size_t)(row0 + 16 * (sc + 1) + i) * 2048); if (PASS == 1) ng[i] = __builtin_nontemporal_load(zg + (size_t)(row0 + 16 * (sc + 1) + i) * 2048); } }
        LDS_WAIT(); asm volatile("" ::: "memory");
        f32x4 acc[8];
#pragma unroll
        for (int et = 0; et < 8; ++et) acc[et] = (f32x4){0.f, 0.f, 0.f, 0.f};
#pragma unroll
        for (int ks = 0; ks < 2; ++ks) { const bf16x8 af = *(const LAS bf16x8*)(xcl + fr * 72 + ks * 32 + 8 * fq);
#pragma unroll
            for (int et = 0; et < 8; ++et) acc[et] = __builtin_amdgcn_mfma_f32_16x16x32_bf16(af, gB[et][ks], acc[et], 0, 0, 0); }
#pragma unroll
        for (int et = 0; et < 8; ++et)
#pragma unroll
            for (int r = 0; r < 4; ++r) gl[(4 * fq + r) * 132 + et * 16 + fr] = acc[et][r];
        LDS_WAIT(); asm volatile("" ::: "memory");
#pragma unroll
        for (int i = 0; i < 16; i += 2) {
            typedef pg8::f32x2 v2;
            const v2 gr = (v2){gl[i * 132 + lane], gl[(i + 1) * 132 + lane]} + gbr, gi = (v2){gl[i * 132 + 64 + lane], gl[(i + 1) * 132 + 64 + lane]} + gbi;
            const v2 tr = gr * (-1.4426950408889634f), ti = gi * (-1.4426950408889634f);
            v2 dr, di; dr.x = __builtin_amdgcn_exp2f(tr.x); dr.y = __builtin_amdgcn_exp2f(tr.y); di.x = __builtin_amdgcn_exp2f(ti.x); di.y = __builtin_amdgcn_exp2f(ti.y);
            dr = dr + 1.0f; di = di + 1.0f;
            v2 r, ig; r.x = __builtin_amdgcn_rcpf(dr.x); r.y = __builtin_amdgcn_rcpf(dr.y); ig.x = __builtin_amdgcn_rcpf(di.x); ig.y = __builtin_amdgcn_rcpf(di.y);
            const v2 la = r * c8;
            v2 em;
            if (small_all) { v2 q = la * 0.0013888889f + 0.0083333338f; q = q * la + 0.041666668f; q = q * la + 0.16666667f; q = q * la + 0.5f; q = q * la + 1.0f; em = q * la; }
            else { em.x = __expf(la.x) - 1.0f; em.y = __expf(la.y) - 1.0f; }
            const v2 av = em + 1.0f, m2 = -em * (em + 2.0f);
            v2 mult; mult.x = __builtin_amdgcn_sqrtf(m2.x); mult.y = __builtin_amdgcn_sqrtf(m2.y);
            const v2 uu = mult * ig * (v2){xc[i], xc[i + 1]};
            const float h0 = av.x * hl + uu.x, h1 = av.y * h0 + uu.y; hl = h1;
            if (PASS == 0) P *= av.x * av.y;
            else { const v2 g = (v2){ag[i], ag[i + 1]};
                const v2 tg = (g * g * 0.044715f + 1.0f) * g * (-1.5957691216f * 1.4426950408889634f);
                v2 dg; dg.x = __builtin_amdgcn_exp2f(tg.x); dg.y = __builtin_amdgcn_exp2f(tg.y); dg = dg + 1.0f;
                v2 rg; rg.x = __builtin_amdgcn_rcpf(dg.x); rg.y = __builtin_amdgcn_rcpf(dg.y);
                const v2 y = (v2){h0, h1} * g * rg;
                YCAT[(size_t)(row0 + 16 * sc + i) * 1024 + ch] = (bf16)f2bf(y.x); YCAT[(size_t)(row0 + 16 * sc + i + 1) * 1024 + ch] = (bf16)f2bf(y.y); }
        }
        LDS_WAIT(); asm volatile("" ::: "memory");
    }
    if (PASS == 0)
        __hip_atomic_store((unsigned long long*)(SUMM + ((size_t)ci * 512 + ch) * 2), ((unsigned long long)__float_as_uint(hl) << 32) | (unsigned long long)__float_as_uint(P), __ATOMIC_RELAXED, __HIP_MEMORY_SCOPE_AGENT);
}

__device__ __forceinline__ void m1_partB(const Args& a, unsigned char* ws, int ci, int w, int lane_) {
    int lane = lane_; asm volatile("" : "+v"(lane));
    const bf16* Z = (const bf16*)(ws + WS_ACT); bf16* YCAT = (bf16*)(ws + WS_XN);
    const int ch = w * 64 + lane, row0 = ci * 128; const bool first = (ci % (SEQ / 128)) == 0;
    {
        float bw[31];
#pragma unroll
        for (int k = 0; k < 31; ++k) bw[k] = a.in[I_BCW][k * 512 + ch];
        const float bb = a.in[I_BCB][ch], ng = a.in[I_BNG][ch], nb = a.in[I_BNB][ch];
        const bf16* zv = Z + 1024 + ch; const bf16* zg = Z + 1536 + ch;
        float win[32];
        win[0] = 0.f; win[1] = 0.f;
#pragma unroll
        for (int j = 2; j < 32; ++j) { float v = 0.f; if (!first) { const size_t row = (size_t)(row0 - 32 + j); v = bf2f(zv[row * 2048]) * fsig(bf2f(zg[row * 2048])); } win[j] = v; }
#pragma unroll 1
        for (int base = 0; base < 128; base += 32) {
            unsigned rvg[32];
#pragma unroll
            for (int j = 0; j < 32; ++j) { const size_t row = (size_t)(row0 + base + j); rvg[j] = (unsigned)__builtin_nontemporal_load(zv + row * 2048) | ((unsigned)__builtin_nontemporal_load(zg + row * 2048) << 16); }
#pragma unroll
            for (int j4 = 0; j4 < 32; j4 += 4) {
                float ac[4], dl[4], vr[4];
#pragma unroll
                for (int q = 0; q < 4; ++q) { const int j = j4 + q; win[j] = bflo(rvg[j]) * fsig(bfhi(rvg[j]));
                    float acc = bb;
#pragma unroll
                    for (int k = 0; k < 31; ++k) acc += bw[k] * win[(j + 2 + k) & 31];
                    ac[q] = acc; }
#pragma unroll
                for (int q = 0; q < 4; ++q) dl[q] = ac[q] - wave_sum(ac[q]) * (1.0f / 64.0f);
#pragma unroll
                for (int q = 0; q < 4; ++q) vr[q] = wave_sum(dl[q] * dl[q]) * (1.0f / 64.0f);
#pragma unroll
                for (int q = 0; q < 4; ++q) { const float y = dl[q] * rsqrtf(vr[q] + EPS) * ng + nb;
                    YCAT[(size_t)(row0 + base + j4 + q) * 1024 + 512 + ch] = (bf16)f2bf(y * fsig(y)); }
            }
        }
    }
}

__device__ __forceinline__ void sg_chunk(const Args& a, unsigned char* ws, LAS unsigned char* lds, int ci, int w, int lane_, int tid_) {
    int lane = lane_, tid = tid_; asm volatile("" : "+v"(lane), "+v"(tid));
    const bf16* Z = (const bf16*)(ws + WS_ACT); bf16* UG = (bf16*)(ws + WS_XN); const bf16* WSB = (const bf16*)(ws + WS_WSB);
    const float* S1 = (const float*)(ws + WS_ST1); const float* S2 = (const float*)(ws + WS_ST2);
    LAS float* sm = (LAS float*)lds;
    LAS bf16* vT = (LAS bf16*)(lds + 1024 + w * 17408);
    const int row0 = ci * 128;
    if (tid < 128) { const size_t row = (size_t)(row0 + tid); float s1 = 0.f, s2 = 0.f;
#pragma unroll
        for (int i = 0; i < 4; ++i) { const f32x4 p = *(const f32x4*)(S1 + row * 16 + 4 * i), q = *(const f32x4*)(S2 + row * 16 + 4 * i); s1 += (p.x + p.y) + (p.z + p.w); s2 += (q.x + q.y) + (q.z + q.w); }
        const float mean = s1 * (1.0f / 1024.0f), var = s2 * (1.0f / 1024.0f) - mean * mean;
        sm[2 * tid] = mean; sm[2 * tid + 1] = rsqrtf(var + EPS); }
    __syncthreads();
    const int fr = lane & 15, fq = lane >> 4;
    bf16x8 yfr[8][4];
#pragma unroll
    for (int tt = 0; tt < 8; ++tt)
#pragma unroll
        for (int ks = 0; ks < 4; ++ks) if (ks < tt / 2 + 1) yfr[tt][ks] = *(const bf16x8*)(WSB + ((size_t)w * 128 + tt * 16 + fr) * 128 + ks * 32 + 8 * fq);
#pragma unroll 1
    for (int hh = 0; hh < 2; ++hh) {
        const int cbase = w * 128 + hh * 64;
        { const int csub = (lane & 7) * 8, sl = lane >> 3;
            float g8[8], b8[8];
#pragma unroll
            for (int e = 0; e < 8; ++e) { g8[e] = a.in[I_CNG][cbase + csub + e]; b8[e] = a.in[I_CNB][cbase + csub + e]; }
#pragma unroll 1
            for (int i0 = 0; i0 < 16; i0 += 8) {
                v4u raw[8];
#pragma unroll
                for (int i = 0; i < 8; ++i) raw[i] = __builtin_nontemporal_load((const v4u*)(Z + (size_t)(row0 + sl + 8 * (i0 + i)) * 2048 + 1024 + cbase + csub));
#pragma unroll
                for (int i = 0; i < 8; ++i) { const int s = sl + 8 * (i0 + i);
                    const float mean = sm[2 * s], rstd = sm[2 * s + 1];
                    const unsigned rw[4] = {raw[i].x, raw[i].y, raw[i].z, raw[i].w};
#pragma unroll
                    for (int e = 0; e < 8; ++e) { const float v = (e & 1) ? bfhi(rw[e >> 1]) : bflo(rw[e >> 1]);
                        vT[(csub + e) * 136 + (s ^ csub)] = (bf16)f2bf((v - mean) * rstd * g8[e] + b8[e]); } }
            }
        }
        LDS_WAIT(); asm volatile("" ::: "memory");
#pragma unroll
        for (int tt = 0; tt < 8; ++tt) {
            const int t = tt * 16 + fr; const size_t row = (size_t)(row0 + t); const float bs = a.in[I_CBS][w * 128 + t];
            u32x2 uu[4];
#pragma unroll
            for (int ct = 0; ct < 4; ++ct) uu[ct] = __builtin_nontemporal_load((const u32x2*)(Z + row * 2048 + cbase + ct * 16 + 4 * fq));
            f32x4 acc[4];
#pragma unroll
            for (int ct = 0; ct < 4; ++ct) acc[ct] = (f32x4){0.f, 0.f, 0.f, 0.f};
#pragma unroll
            for (int ks = 0; ks < tt / 2 + 1; ++ks) {
#pragma unroll
                for (int ct = 0; ct < 4; ++ct) { const bf16x8 xf = *(const LAS bf16x8*)(vT + (ct * 16 + fr) * 136 + ((ks * 32 + 8 * fq) ^ (((ct * 16 + fr) >> 3) << 3)));
                    acc[ct] = __builtin_amdgcn_mfma_f32_16x16x32_bf16(xf, yfr[tt][ks], acc[ct], 0, 0, 0); }
            }
#pragma unroll
            for (int ct = 0; ct < 4; ++ct) { const int cc = cbase + ct * 16 + 4 * fq;
                u32x2 o; o.x = pg8::cvt_pk_bf16(bflo(uu[ct].x) * (acc[ct][0] + bs), bfhi(uu[ct].x) * (acc[ct][1] + bs)); o.y = pg8::cvt_pk_bf16(bflo(uu[ct].y) * (acc[ct][2] + bs), bfhi(uu[ct].y) * (acc[ct][3] + bs));
                *(u32x2*)(UG + row * 1024 + cc) = o; }
        }
        LDS_WAIT(); asm volatile("" ::: "memory");
    }
    __syncthreads();
}

__global__ void __launch_bounds__(NTHR, 2) mega_fwd(Args args) {
    extern __shared__ __attribute__((aligned(16))) unsigned char lds_raw[];
    LAS unsigned char* lds = (LAS unsigned char*)lds_raw;
    volatile LAS unsigned* MISC = (volatile LAS unsigned*)(lds + MISC_OFF);
    const int tid = threadIdx.x, lane = tid & 63, wave = __builtin_amdgcn_readfirstlane(tid >> 6);
    const int G = gridDim.x, bx = blockIdx.x;
    const int gw = bx * NWAVES + wave, NGW = G * NWAVES;
    unsigned char* ws = args.ws;
    gu32* ctl = (gu32*)(ws + WS_CTL);
    for (int u = tid; u < (LDS_BYTES - LDSCTL_OFF) / 4; u += NTHR) ((LAS unsigned*)(lds + LDSCTL_OFF))[u] = 0u;
    __syncthreads();
    XcdBarrier bar = xcd_barrier_post((unsigned*)(ctl + CW_BAR), MISC + 8);
#define GRID_BAR() xcd_barrier(bar)
    if (tid == 0) MISC[16] = __hip_atomic_fetch_add((unsigned*)(ctl + CW_XRANK) + 64 * (bar.x & 7u), 1u, __ATOMIC_RELAXED, __HIP_MEMORY_SCOPE_AGENT);
    int cv = bx; bool loc_ok = false;
    unsigned* lb_cnt = (unsigned*)(ctl + CW_LBAR); unsigned* lb_gen = lb_cnt + 64;
#define LOC_BAR() do { if (loc_ok) { \
        asm volatile("s_waitcnt vmcnt(0)" ::: "memory"); __syncthreads(); \
        if (tid == 0) { __builtin_amdgcn_s_waitcnt(0); const unsigned old_ = xb_add(lb_cnt, 1u), g_ = old_ / 4u; \
            if (old_ + 1u == (g_ + 1u) * 4u) xb_add(lb_gen, 1u); \
            else { unsigned sp_ = 0u; while (xb_ld(lb_gen) == g_) { __builtin_amdgcn_s_sleep(1); if (++sp_ > (1u << 24)) break; } } \
            __builtin_amdgcn_fence(__ATOMIC_ACQUIRE, "agent"); asm volatile("s_waitcnt vmcnt(0)" ::: "memory"); } \
        __syncthreads(); } else xcd_barrier(bar); } while (0)

    float* PAR = (float*)(ws + WS_PAR);
    bf16* XB = (bf16*)(ws + WS_XB);
    bf16* XN = (bf16*)(ws + WS_XN); bf16* ACT = (bf16*)(ws + WS_ACT); bf16* YB = (bf16*)(ws + WS_Y);
    float* ST0 = (float*)(ws + WS_ST0); float* ST1 = (float*)(ws + WS_ST1); float* ST2 = (float*)(ws + WS_ST2);
#define PARP(l, s, q) (PAR + ((size_t)((l) * 3 + (s)) * 2) * 3072 + (q) * 1024)

    {
        { float* MODP = (float*)(ws + WS_MODP); const float* cp = args.in[I_C];
            for (int it = gw; it < 2 * 36 * 32; it += NGW) { const int l = it / 1152, rem = it % 1152, jb = rem / 32, kw = rem % 32;
                const float* wp = args.in[I_ADAW] + ((size_t)l * 1024 + kw * 32) * 9216 + jb * 256 + 4 * lane;
                f32x4 a0 = (f32x4){0.f, 0.f, 0.f, 0.f}, a1 = a0;
#pragma unroll 8
                for (int k = 0; k < 32; ++k) { const f32x4 wv = __builtin_nontemporal_load((const f32x4*)(wp + (size_t)k * 9216));
                    const float c0 = cp[kw * 32 + k], c1 = cp[1024 + kw * 32 + k];
                    const float s0 = c0 / (1.0f + expf(-c0)), s1 = c1 / (1.0f + expf(-c1));
                    a0 = a0 + wv * s0; a1 = a1 + wv * s1; }
                *(f32x4*)(MODP + ((size_t)(kw * 2 + l) * 2 + 0) * 9216 + jb * 256 + 4 * lane) = a0;
                *(f32x4*)(MODP + ((size_t)(kw * 2 + l) * 2 + 1) * 9216 + jb * 256 + 4 * lane) = a1; } }
    }
    GRID_BAR();
    { bool even = (G == 256);
#pragma unroll
        for (int j = 0; j < 8; ++j) even = even && (__hip_atomic_load((unsigned*)(ctl + CW_XRANK) + 64 * j, __ATOMIC_RELAXED, __HIP_MEMORY_SCOPE_AGENT) == 32u);
        loc_ok = even; if (even) cv = (int)(bar.x & 7u) + 8 * (int)MISC[16];
        cv = __builtin_amdgcn_readfirstlane(cv); }
    const int gm_ = (cv >> 3) & 7, gq_ = cv >> 6;
    const int hp = (G == 256) ? 2 * (16 * (cv & 7) + 8 * (gq_ >> 1) + gm_) + (gq_ & 1) : bx;
    lb_cnt = (unsigned*)(ctl + CW_LBAR) + 128 * (8 * (cv & 7) + gm_); lb_gen = lb_cnt + 64;
    const int gwm = hp * NWAVES + wave;
    {
        const float* MODP = (const float*)(ws + WS_MODP);
        const int per = (2 * 3 * 2 * 1024 + G - 1) / G;
        for (int t = bx * per + tid; tid < per && t < 2 * 3 * 2 * 1024 && t < (bx + 1) * per; t += NTHR) {
            const int c = t & 1023, b = (t >> 10) & 1, ls = t >> 11, l = ls / 3, s = ls % 3;
            float v[3];
#pragma unroll
            for (int q = 0; q < 3; ++q) { float pv[32];
#pragma unroll
                for (int kw = 0; kw < 32; ++kw) pv[kw] = MODP[((size_t)(kw * 2 + l) * 2 + b) * 9216 + s * 3072 + q * 1024 + c];
                float acc = args.in[I_ADAB][l * 9216 + s * 3072 + q * 1024 + c];
#pragma unroll
                for (int kw = 0; kw < 32; ++kw) acc += pv[kw];
                v[q] = acc; }
            const float resw = (s == 1) ? 1.0f : 0.5f;
            float* p = PAR + ((size_t)(l * 3 + s) * 2 + b) * 3072 + c;
            p[0] = resw * (1.0f + v[2]) * args.in[I_NPOST][(l * 3 + s) * 1024 + c];
            p[1024] = args.in[I_NPRE][(l * 3 + s) * 1024 + c] * (1.0f + v[1]);
            p[2048] = v[0];
        }
    }
    {
        LAS float* scr = (LAS float*)(lds + wave * 16384);
        constexpr int NITEMS = 4 * (D / 64) * (2 * FF / 32) + 4 * (FF / 64) * (D / 32) + 2 * (D / 64) * (2048 / 32) + 2 * (D / 64) * (D / 32);
        if (gw < NITEMS) {
            TItem cur = p0_decode(args, ws, gw); float v[32]; p0_item_load(cur, lane, v);
#pragma unroll 1
            for (int it = gw; it < NITEMS; it += NGW) {
                const int nit = it + NGW; const bool more = nit < NITEMS;
                TItem nxt = cur; float vn[32];
                if (more) { nxt = p0_decode(args, ws, nit); p0_item_load(nxt, lane, vn); }
                p0_item_store(cur, lane, v, scr);
                if (more) {
#pragma unroll
                    for (int i = 0; i < 32; ++i) v[i] = vn[i];
                    cur = nxt; }
            }
        }
        { bf16* WSB = (bf16*)(ws + WS_WSB); const float* wsp = args.in[I_CWS];
            for (int e = bx * NTHR + tid; e < 8 * 128 * 128; e += G * NTHR) { const int s = e & 127, t = (e >> 7) & 127; WSB[e] = (bf16)f2bf(s <= t ? wsp[e] : 0.f); } }
        { bf16* GWT = (bf16*)(ws + WS_GWT); const float* gp = args.in[I_AGW];
            for (int e = bx * NTHR + tid; e < 8 * 128 * 64; e += G * NTHR) { const int d = e & 63, ee = (e >> 6) & 127, h = e >> 13; GWT[e] = (bf16)f2bf(gp[((size_t)h * 64 + d) * 128 + ee]); } }
    }
    GRID_BAR();
    trans_phase<false, true, 0, 1>(gwm, NGW, lane, args.in[I_X], XB, nullptr, nullptr, nullptr, PARP(0, 0, 1), PARP(0, 0, 2), XN);
    LOC_BAR();

#pragma unroll 1
    for (int l = 0; l < 2; ++l) {
        unsigned char* wl = ws + WS_W + (size_t)l * LAYER_W_BYTES;
#pragma unroll 1
        for (int s = 0; s < 3; ++s) {
            if (s != 1) {
                const int fi = s >> 1;
                if (l == 0 && s == 2) {
                    if (tid == 0) { unsigned sp_ = 0u; while (__hip_atomic_load((unsigned*)(ctl + CW_M1DONE), __ATOMIC_RELAXED, __HIP_MEMORY_SCOPE_AGENT) < (unsigned)G) { __builtin_amdgcn_s_sleep(2); if (++sp_ > (1u << 24)) break; } }
                    __syncthreads(); }
                { pg8::Gemm g{XN, (const bf16*)(wl + LW_W13 + (size_t)fi * W13_BYTES), M, 2 * FF, D}; pg8::StaticOrder S; S.init(M, 2 * FF, G, cv);
                    pg8::EpiX<1> E{ACT, FF, nullptr, nullptr, nullptr};
                    pg8::gemm_phase<pg8::EpiX<1>, pg8::StaticOrder, true, true>(lds, g, S, E); }
                LOC_BAR();
                { pg8::Gemm g{ACT, (const bf16*)(wl + LW_W2 + (size_t)fi * W2_BYTES), M, D, FF}; pg8::StaticOrder S; S.init(M, D, G, cv);
                    pg8::EpiX<2> E{YB, D, nullptr, ST0, nullptr};
                    pg8::gemm_phase<pg8::EpiX<2>, pg8::StaticOrder, true, true>(lds, g, S, E); }
                LOC_BAR();
            } else if (l == 0) {
                { pg8::Gemm g{XN, (const bf16*)(wl + LW_WIN), M, 2048, D}; pg8::StaticOrder S; S.init(M, 2048, G, cv);
                    pg8::EpiX<0> E{ACT, 2048, nullptr, nullptr, nullptr};
                    pg8::gemm_phase<pg8::EpiX<0>, pg8::StaticOrder, true, true>(lds, g, S, E); }
                GRID_BAR();
                for (int ci = hp; ci < NCHUNK; ci += G) m1_partA<0>(args, ws, lds, ci, wave, lane);
                asm volatile("s_waitcnt vmcnt(0)" ::: "memory"); __syncthreads();
                if (tid == 0) __hip_atomic_fetch_add((unsigned*)(ctl + CW_M1PUB), 1u, __ATOMIC_RELAXED, __HIP_MEMORY_SCOPE_AGENT);
                for (int ci = hp; ci < NCHUNK; ci += G) m1_partB(args, ws, ci, wave, lane);
                if (tid == 0) { unsigned sp_ = 0u; while (__hip_atomic_load((unsigned*)(ctl + CW_M1PUB), __ATOMIC_RELAXED, __HIP_MEMORY_SCOPE_AGENT) < (unsigned)G) { __builtin_amdgcn_s_sleep(2); if (++sp_ > (1u << 24)) break; }
                    __builtin_amdgcn_fence(__ATOMIC_ACQUIRE, "agent"); asm volatile("s_waitcnt vmcnt(0)" ::: "memory"); }
                __syncthreads();
                for (int ci = hp; ci < NCHUNK; ci += G) m1_partA<1>(args, ws, lds, ci, wave, lane);
                asm volatile("s_waitcnt vmcnt(0)" ::: "memory"); __syncthreads();
                if (tid == 0) __hip_atomic_fetch_add((unsigned*)(ctl + CW_M1DONE), 1u, __ATOMIC_RELAXED, __HIP_MEMORY_SCOPE_AGENT);
                LOC_BAR();
                { pg8::Gemm g{XN, (const bf16*)(wl + LW_WOUT), M, D, D}; pg8::StaticOrder S; S.init(M, D, G, cv);
                    pg8::EpiX<2> E{YB, D, nullptr, ST0, nullptr};
                    pg8::gemm_phase<pg8::EpiX<2>, pg8::StaticOrder, true, true>(lds, g, S, E); }
                LOC_BAR();
            } else {
                { pg8::Gemm g{XN, (const bf16*)(wl + LW_WIN), M, 2048, D}; pg8::StaticOrder S; S.init(M, 2048, G, cv);
                    pg8::EpiX<3> E{ACT, 2048, args.in[I_CBIN], ST1, ST2};
                    pg8::gemm_phase<pg8::EpiX<3>, pg8::StaticOrder, true, true>(lds, g, S, E); }
                LOC_BAR();
                for (int ci = hp; ci < NCHUNK; ci += G) sg_chunk(args, ws, lds, ci, wave, lane, tid);
                LOC_BAR();
                { pg8::Gemm g{XN, (const bf16*)(wl + LW_WOUT), M, D, D}; pg8::StaticOrder S; S.init(M, D, G, cv);
                    pg8::EpiX<2> E{YB, D, nullptr, ST0, nullptr};
                    pg8::gemm_phase<pg8::EpiX<2>, pg8::StaticOrder, true, true>(lds, g, S, E); }
                LOC_BAR();
            }
            if (l == 1 && s == 2) trans_phase<true, false, 1, 2>(gwm, NGW, lane, XB, args.out, YB, ST0, PARP(l, s, 0), nullptr, nullptr, nullptr);
            else { const int nl = (s == 2) ? l + 1 : l, ns = (s == 2) ? 0 : s + 1;
                trans_phase<true, true, 1, 1>(gwm, NGW, lane, XB, XB, YB, ST0, PARP(l, s, 0), PARP(nl, ns, 1), PARP(nl, ns, 2), XN);
                LOC_BAR(); }
        }
    }
    cg::this_grid().sync();
}

extern "C" void kernel_launch(void* const* d_in, const int* in_sizes, int n_in, void* d_out, int out_size, void* d_ws, size_t ws_size, hipStream_t stream) {
    static int grid = 0;
    if (grid == 0) {
        if (n_in != 26 || in_sizes[0] != M * D || out_size != M * D || ws_size < WS_END) { fprintf(stderr, "kernel_launch: unexpected shapes (n_in %d, in0 %d, out %d, ws %zu)\n", n_in, n_in > 0 ? in_sizes[0] : -1, out_size, ws_size); grid = -1; return; }
        int dev = 0, cus = 0, per_cu = 0;
        if (hipGetDevice(&dev) != hipSuccess || hipDeviceGetAttribute(&cus, hipDeviceAttributeMultiprocessorCount, dev) != hipSuccess) { grid = -1; return; }
        if (hipFuncSetAttribute((const void*)mega_fwd, hipFuncAttributeMaxDynamicSharedMemorySize, LDS_BYTES) != hipSuccess) { fprintf(stderr, "kernel_launch: hipFuncSetAttribute failed\n"); grid = -1; return; }
        if (hipOccupancyMaxActiveBlocksPerMultiprocessor(&per_cu, (const void*)mega_fwd, NTHR, LDS_BYTES) != hipSuccess || per_cu < 1) { fprintf(stderr, "kernel_launch: occupancy query says %d\n", per_cu); per_cu = 1; }
        (void)hipGetLastError();
        grid = cus;
    }
    if (grid < 0) return;
    (void)hipMemsetAsync((char*)d_ws + WS_CTL, 0, CTL_ZERO_BYTES, stream);
    Args a{};
    for (int i = 0; i < 26; ++i) a.in[i] = (const float*)d_in[i];
    a.out = (float*)d_out; a.ws = (unsigned char*)d_ws;
    void* kargs[] = {&a};
    const hipError_t le = hipLaunchCooperativeKernel((const void*)mega_fwd, dim3(grid), dim3(NTHR), kargs, LDS_BYTES, stream);
    if (le != hipSuccess) fprintf(stderr, "kernel_launch: cooperative launch failed: %s (grid %d)\n", hipGetErrorName(le), grid);
}
```
